# Optimizing an MI355X kernel written in HIP

```python
import jax, jax.numpy as jnp
from jax import lax
import numpy as np

D_MODEL = 1024
BATCH = 4
SEQ = 4096
DEPTH = 2

CTX_LEN = 256
GRID_W = 64
N_Q_HEADS = 8
N_KV_HEADS = 2
HEAD_DIM = 64
Q_PER_KV = N_Q_HEADS // N_KV_HEADS
ATTN_WIDTH = N_Q_HEADS * HEAD_DIM
KV_WIDTH = N_KV_HEADS * HEAD_DIM
WINDOW = 128
BLOCK = 128
ROPE_BASE = 10000.0
POOL_GROUPS = 4
POOL_GROUP_DIM = 64
POOL_WIDTH = POOL_GROUPS * POOL_GROUP_DIM
POOL_WINDOWS = (2, 4, 8, 16)
FOURIER_GROUPS = 4
FOURIER_GROUP_DIM = 64
FOURIER_WIDTH = FOURIER_GROUPS * FOURIER_GROUP_DIM
N_BRANCHES = 3
IN_SPLITS = (KV_WIDTH, 2 * KV_WIDTH, 2 * KV_WIDTH + ATTN_WIDTH,
             2 * KV_WIDTH + ATTN_WIDTH + POOL_WIDTH,
             2 * KV_WIDTH + ATTN_WIDTH + POOL_WIDTH + FOURIER_WIDTH)
IN_WIDTH = 2 * KV_WIDTH + ATTN_WIDTH + POOL_WIDTH + FOURIER_WIDTH + N_BRANCHES * D_MODEL
D_FF = 2816
CONV_WIDTH = 3
N_MOD = 6
EPS = 1e-6
NEG_INF = -1e30

kernel_name = "hybrid_gated_parallel_dit_block"


def rms_norm(x, g):
    xf = x.astype(jnp.float32)
    y = xf * lax.rsqrt(jnp.mean(xf * xf, axis=-1, keepdims=True) + EPS)
    return (y * g.astype(jnp.float32)).astype(x.dtype)


def adaln_params(cond, w_mod, b_mod):
    m = jax.nn.silu(cond) @ w_mod + b_mod
    return jnp.split(m[..., None, :], N_MOD, axis=-1)


def modulate(h, shift, scale):
    return h * (1 + scale) + shift


def axial_rope_tables(n_tokens):
    rows = n_tokens // GRID_W
    row = jnp.repeat(jnp.arange(rows, dtype=jnp.int32), GRID_W).astype(jnp.float32)
    col = jnp.tile(jnp.arange(GRID_W, dtype=jnp.int32), rows).astype(jnp.float32)
    n_freq = HEAD_DIM // 4
    inv_freq = ROPE_BASE ** (-jnp.arange(n_freq, dtype=jnp.float32) / n_freq)
    ang = jnp.stack([row[:, None] * inv_freq[None, :], col[:, None] * inv_freq[None, :]], axis=1)
    return jnp.cos(ang), jnp.sin(ang)


def apply_rope(x, cos, sin):
    B, T, H, _ = x.shape
    xr = x.astype(jnp.float32).reshape(B, T, H, 2, 2, HEAD_DIM // 4)
    c = cos[None, :, None, :, :]
    s = sin[None, :, None, :, :]
    x1, x2 = xr[..., 0, :], xr[..., 1, :]
    out = jnp.stack([x1 * c - x2 * s, x2 * c + x1 * s], axis=-2)
    return out.reshape(x.shape).astype(x.dtype)


def sink_column(sink, lead_shape):
    s = sink.astype(jnp.float32).reshape((1, N_KV_HEADS, Q_PER_KV) + (1,) * (len(lead_shape) - 2))
    return jnp.broadcast_to(s, tuple(lead_shape) + (1,))


def latent_attention(q, k, v, kc, vc, sink):
    B, T = q.shape[:2]
    nb = T // BLOCK
    ctx_len = kc.shape[1]
    scale = HEAD_DIM ** -0.5
    qb = q.reshape(B, nb, BLOCK, N_KV_HEADS, Q_PER_KV, HEAD_DIM)

    def band(a):
        a = a.reshape(B, nb, BLOCK, N_KV_HEADS, HEAD_DIM)
        pad = jnp.zeros_like(a[:, :1])
        ap = jnp.concatenate([pad, a, pad], axis=1)
        return jnp.concatenate([ap[:, :-2], ap[:, 1:-1], ap[:, 2:]], axis=2)

    kb, vb = band(k), band(v)
    s_lat = jnp.einsum('bnqhgd,bnkhd->bhgnqk', qb, kb).astype(jnp.float32) * scale
    blk = jnp.arange(nb, dtype=jnp.int32)[:, None]
    qpos = blk * BLOCK + jnp.arange(BLOCK, dtype=jnp.int32)[None, :]
    kpos = (blk - 1) * BLOCK + jnp.arange(3 * BLOCK, dtype=jnp.int32)[None, :]
    rel = kpos[:, None, :] - qpos[:, :, None]
    valid = (jnp.abs(rel) <= WINDOW) & (kpos[:, None, :] >= 0) & (kpos[:, None, :] < T)
    s_lat = jnp.where(valid, s_lat, NEG_INF)
    s_ctx = jnp.einsum('bnqhgd,bchd->bhgnqc', qb, kc).astype(jnp.float32) * scale
    s_all = jnp.concatenate([s_lat, s_ctx, sink_column(sink, s_lat.shape[:-1])], axis=-1)
    p = jax.nn.softmax(s_all, axis=-1)
    p_lat = p[..., :3 * BLOCK].astype(v.dtype)
    p_ctx = p[..., 3 * BLOCK:3 * BLOCK + ctx_len].astype(v.dtype)
    o = (jnp.einsum('bhgnqk,bnkhd->bnqhgd', p_lat, vb)
         + jnp.einsum('bhgnqc,bchd->bnqhgd', p_ctx, vc))
    return o.reshape(B, T, ATTN_WIDTH)


def context_attention(qc, kc, vc, sink):
    B, L = qc.shape[:2]
    scale = HEAD_DIM ** -0.5
    qg = qc.reshape(B, L, N_KV_HEADS, Q_PER_KV, HEAD_DIM)
    s = jnp.einsum('bqhgd,bkhd->bhgqk', qg, kc).astype(jnp.float32) * scale
    s_all = jnp.concatenate([s, sink_column(sink, s.shape[:-1])], axis=-1)
    p = jax.nn.softmax(s_all, axis=-1)[..., :L].astype(vc.dtype)
    o = jnp.einsum('bhgqk,bkhd->bqhgd', p, vc)
    return o.reshape(B, L, ATTN_WIDTH)


def multiscale_pool(u, pool_w, pool_scale):
    B, T = u.shape[:2]
    ug = u.reshape(B, T, POOL_GROUPS, POOL_GROUP_DIM).astype(jnp.float32)
    cs = jnp.concatenate([jnp.zeros_like(ug[:, :1]), jnp.cumsum(ug, axis=1)], axis=1)
    w = jnp.array(POOL_WINDOWS, dtype=jnp.int32)[None, :]
    t = jnp.arange(T, dtype=jnp.int32)[:, None]
    lo = jnp.clip(t - w // 2, 0, T)
    hi = jnp.clip(t - w // 2 + w, 0, T)
    gidx = jnp.arange(POOL_GROUPS, dtype=jnp.int32)[None, :]
    win_sum = cs[:, hi, gidx] - cs[:, lo, gidx]
    cnt = (hi - lo).astype(jnp.float32)[None, :, :, None]
    pooled = (win_sum / cnt - ug).astype(u.dtype)
    y = jnp.einsum('btgc,gcd->btgd', pooled, pool_w).reshape(B, T, POOL_WIDTH)
    return y * pool_scale


def fourier_mix(f):
    B, T = f.shape[:2]
    fg = f.reshape(B, T, FOURIER_GROUPS, FOURIER_GROUP_DIM).astype(jnp.float32)
    y = jnp.fft.fft2(fg, axes=(1, 3), norm='ortho').real
    return y.astype(f.dtype).reshape(B, T, FOURIER_WIDTH)


def merge_branches(o_attn, pool_in, four_in, gate_in, pool_w, pool_scale,
                   w_br_attn, w_br_pool, w_br_four, w_out):
    g_a, g_p, g_f = jnp.split(jax.nn.sigmoid(gate_in), N_BRANCHES, axis=-1)
    y = (g_a * (o_attn @ w_br_attn)
         + g_p * (multiscale_pool(pool_in, pool_w, pool_scale) @ w_br_pool)
         + g_f * (fourier_mix(four_in) @ w_br_four))
    return y @ w_out


def dwconv_centred(u, w):
    T = u.shape[1]
    up = jnp.pad(u, ((0, 0), (1, 1), (0, 0)))
    return up[:, :T] * w[0] + up[:, 1:T + 1] * w[1] + up[:, 2:] * w[2]


def conv_ffn(h, w_up, conv_w, w_down):
    a = dwconv_centred(h @ w_up, conv_w)
    val, gate = jnp.split(a, 2, axis=-1)
    return (val * jax.nn.silu(gate)) @ w_down


def setup_inputs(seed: int = 0) -> dict:
    key = jax.random.key(seed)
    ks = jax.random.split(key, 24)
    f32 = jnp.float32
    n = lambda k, shape, s: jax.random.normal(k, shape, f32) * s
    return {
        'x': n(ks[0], (BATCH, SEQ, D_MODEL), 1.0),
        'c': n(ks[1], (BATCH, D_MODEL), 1.0),
        'ctx': n(ks[2], (BATCH, CTX_LEN, D_MODEL), 1.0),
        'c_ctx': n(ks[3], (D_MODEL,), 1.0),
        'w_mod': n(ks[4], (DEPTH, D_MODEL, N_MOD * D_MODEL), 0.5 * D_MODEL ** -0.5),
        'b_mod': n(ks[5], (DEPTH, N_MOD * D_MODEL), 0.02),
        'norm_mix': 1.0 + n(ks[6], (DEPTH, D_MODEL), 0.02),
        'norm_ffn': 1.0 + n(ks[7], (DEPTH, D_MODEL), 0.02),
        'w_in': n(ks[8], (DEPTH, D_MODEL, IN_WIDTH), D_MODEL ** -0.5),
        'attn_sink': n(ks[9], (DEPTH, N_Q_HEADS), 0.5),
        'pool_w': n(ks[10], (DEPTH, POOL_GROUPS, POOL_GROUP_DIM, POOL_GROUP_DIM), POOL_GROUP_DIM ** -0.5),
        'pool_scale': 1.0 + n(ks[11], (DEPTH, POOL_WIDTH), 0.02),
        'w_br_attn': n(ks[12], (DEPTH, ATTN_WIDTH, D_MODEL), ATTN_WIDTH ** -0.5),
        'w_br_pool': n(ks[13], (DEPTH, POOL_WIDTH, D_MODEL), POOL_WIDTH ** -0.5),
        'w_br_four': n(ks[14], (DEPTH, FOURIER_WIDTH, D_MODEL), FOURIER_WIDTH ** -0.5),
        'w_out': n(ks[15], (DEPTH, D_MODEL, D_MODEL), D_MODEL ** -0.5),
        'w_up': n(ks[16], (DEPTH, D_MODEL, 2 * D_FF), D_MODEL ** -0.5),
        'conv_w': n(ks[17], (DEPTH, CONV_WIDTH, 2 * D_FF), CONV_WIDTH ** -0.5),
        'w_down': n(ks[18], (DEPTH, D_FF, D_MODEL), D_FF ** -0.5),
        'norm_final': 1.0 + n(ks[19], (D_MODEL,), 0.02),
    }


def reference(x, c, ctx, c_ctx, w_mod, b_mod, norm_mix, norm_ffn, w_in, attn_sink, pool_w, pool_scale,
              w_br_attn, w_br_pool, w_br_four, w_out, w_up, conv_w, w_down, norm_final):
    B, T, _ = x.shape
    cos, sin = axial_rope_tables(T)
    xc = ctx
    for l in range(DEPTH):
        last = l == DEPTH - 1
        sh1, sc1, g1, sh2, sc2, g2 = adaln_params(c, w_mod[l], b_mod[l])
        csh1, csc1, cg1, csh2, csc2, cg2 = adaln_params(c_ctx, w_mod[l], b_mod[l])

        h = modulate(rms_norm(x, norm_mix[l]), sh1, sc1)
        hc = modulate(rms_norm(xc, norm_mix[l]), csh1, csc1)
        k, v, q, u, f, gt = jnp.split(h @ w_in[l], IN_SPLITS, axis=-1)
        if last:
            kc, vc = jnp.split(hc @ w_in[l][:, :2 * KV_WIDTH], 2, axis=-1)
        else:
            kc, vc, qc, uc, fc, gtc = jnp.split(hc @ w_in[l], IN_SPLITS, axis=-1)
        L = hc.shape[1]
        q = apply_rope(q.reshape(B, T, N_Q_HEADS, HEAD_DIM), cos, sin)
        k = apply_rope(k.reshape(B, T, N_KV_HEADS, HEAD_DIM), cos, sin)
        v = v.reshape(B, T, N_KV_HEADS, HEAD_DIM)
        kc = kc.reshape(B, L, N_KV_HEADS, HEAD_DIM)
        vc = vc.reshape(B, L, N_KV_HEADS, HEAD_DIM)
        o = latent_attention(q, k, v, kc, vc, attn_sink[l])
        x = x + g1 * merge_branches(o, u, f, gt, pool_w[l], pool_scale[l],
                                    w_br_attn[l], w_br_pool[l], w_br_four[l], w_out[l])
        if not last:
            oc = context_attention(qc.reshape(B, L, N_Q_HEADS, HEAD_DIM), kc, vc, attn_sink[l])
            xc = xc + cg1 * merge_branches(oc, uc, fc, gtc, pool_w[l], pool_scale[l],
                                           w_br_attn[l], w_br_pool[l], w_br_four[l], w_out[l])

        hf = modulate(rms_norm(x, norm_ffn[l]), sh2, sc2)
        x = x + g2 * conv_ffn(hf, w_up[l], conv_w[l], w_down[l])
        if not last:
            hcf = modulate(rms_norm(xc, norm_ffn[l]), csh2, csc2)
            xc = xc + cg2 * conv_ffn(hcf, w_up[l], conv_w[l], w_down[l])
    return rms_norm(x, norm_final)
```

```cpp
#include <hip/hip_runtime.h>
#include <hip/hip_cooperative_groups.h>
#include <cstdio>
namespace cg = cooperative_groups;
#ifndef PROBE
#define PROBE 0
#endif

#define LAS __attribute__((address_space(3)))
typedef unsigned short bf16_t;
typedef short bf16x8 __attribute__((ext_vector_type(8)));
typedef float f32x2 __attribute__((ext_vector_type(2)));
typedef float f32x4 __attribute__((ext_vector_type(4)));
typedef float f32x16 __attribute__((ext_vector_type(16)));
typedef unsigned u32x2 __attribute__((ext_vector_type(2)));
typedef unsigned u32x4 __attribute__((ext_vector_type(4)));

constexpr int NL = 16384, NCX = 1024, NR = NL + NCX, DM = 1024;
constexpr int INW = 4352, DFF = 2816, DFH = 1408;
constexpr int P1LD = 1280;
constexpr int LDS_BYTES = 147456 + 1024, PRM_OFF = 147456;
constexpr float LOG2E = 1.4426950408889634f;

constexpr size_t MiB = 1048576;
constexpr size_t OFF_MOD = 0;
constexpr size_t OFF_ROPE = 262144;
constexpr size_t OFF_TW = 262144 + 16384;
constexpr size_t OFF_BAR = 1 * MiB;
constexpr size_t OFF_XC = 2 * MiB;
constexpr size_t OFF_W = 6 * MiB;
constexpr size_t LW_WIN = 0, LW_WM = (size_t)INW * 1024 * 2, LW_WO = LW_WM + (size_t)1024 * 1280 * 2, LW_WUP = LW_WO + (size_t)1024 * 1024 * 2,
                 LW_WD = LW_WUP + (size_t)5632 * 1024 * 2, LW = LW_WD + (size_t)1024 * DFF * 2;
constexpr size_t OFF_H = 65 * MiB;
constexpr size_t OFF_R = 99 * MiB;
constexpr size_t OFF_P1 = OFF_R;
constexpr size_t OFF_AM = OFF_R + 85 * MiB / 2;
constexpr size_t OFF_YM = OFF_AM + 85 * MiB / 2;
constexpr size_t OFF_ACT = OFF_R;
constexpr size_t OFF_HB = OFF_R + 94 * MiB;
constexpr size_t OFF_PART = 198 * MiB;
constexpr size_t OFF_GC = 218 * MiB;
static_assert(OFF_W + 2 * LW == OFF_H, "weights region");
static_assert(OFF_YM + 34 * MiB <= 256 * MiB && OFF_ACT + (size_t)NR * DFF * 2 <= OFF_HB && OFF_HB + 4 * MiB <= 256 * MiB, "ws");

struct Params {
    const float *x, *c, *ctx, *c_ctx, *w_mod, *b_mod, *norm_mix, *norm_ffn, *w_in, *attn_sink, *pool_w, *pool_scale,
        *w_br_attn, *w_br_pool, *w_br_four, *w_out, *w_up, *conv_w, *w_down, *norm_final;
    float* out; unsigned char* ws; int ph_lo, ph_hi;
};

__device__ __forceinline__ unsigned pk2(float lo, float hi) { unsigned r; asm volatile("v_cvt_pk_bf16_f32 %0, %1, %2" : "=v"(r) : "v"(lo), "v"(hi)); return r; }
__device__ __forceinline__ float bflo(unsigned w) { return __uint_as_float(w << 16); }
__device__ __forceinline__ float bfhi(unsigned w) { return __uint_as_float(w & 0xffff0000u); }
__device__ __forceinline__ float wave_sum(float v) {
#pragma unroll
    for (int o = 1; o < 64; o <<= 1) v += __shfl_xor(v, o);
    return v;
}
__device__ __forceinline__ Params load_params(LAS const Params* lp) { Params p;
#pragma unroll
    for (int i = 0; i < 23; ++i) ((unsigned long long*)&p)[i] = ((LAS const unsigned long long*)lp)[i];
    return p; }
__device__ __forceinline__ int otid() { int t = threadIdx.x; asm volatile("" : "+v"(t)); return t; }
template <class T> __device__ __forceinline__ T* uptr(T* q) { const unsigned long long v = (unsigned long long)q; const unsigned lo = __builtin_amdgcn_readfirstlane((unsigned)v), hi = __builtin_amdgcn_readfirstlane((unsigned)(v >> 32)); return (T*)(((unsigned long long)hi << 32) | lo); }
__device__ __forceinline__ float xor32(float v, bool upper) { const unsigned u = __builtin_bit_cast(unsigned, v); const auto r = __builtin_amdgcn_permlane32_swap(u, u, false, false); return __builtin_bit_cast(float, upper ? r[0] : r[1]); }
__device__ __forceinline__ float fast_sigmoid(float x) { return __builtin_amdgcn_rcpf(1.0f + __builtin_amdgcn_exp2f(-x * LOG2E)); }


#define XB_TMO      128
#define XB_XCNT(j)  (256  + 64 * (j))
#define XB_XSUB(j)  (1280 + 64 * (j))
#define XB_XGEN(j)  (2304 + 64 * (j))
#define XB_TOP      3328
#define XB_TOPGEN   3392
#define XCD_BAR_WORDS 3456
#define XB_SPIN_CAP (1u << 18)
__device__ __forceinline__ unsigned xb_ld(unsigned* p)              { return __hip_atomic_load(p, __ATOMIC_RELAXED, __HIP_MEMORY_SCOPE_AGENT); }
__device__ __forceinline__ unsigned xb_add(unsigned* p, unsigned v) { return __hip_atomic_fetch_add(p, v, __ATOMIC_RELAXED, __HIP_MEMORY_SCOPE_AGENT); }
__device__ __forceinline__ unsigned xb_xcc_id() { return (unsigned)__builtin_amdgcn_s_getreg((3 << 11) | 20) & 0xFu; }
#define XB_SPIN(cond, bar) do { unsigned _sp = 0; while (cond) { __builtin_amdgcn_s_sleep(1); \
    if ((++_sp & 255u) == 0u) { if (xb_ld(&(bar)[XB_TMO])) break; if (_sp > XB_SPIN_CAP) { atomicAdd(&(bar)[XB_TMO], 1u); break; } } } } while (0)
struct XcdBarrier { unsigned* bar; unsigned x; volatile LAS unsigned* st; };
__device__ __forceinline__ XcdBarrier xcd_barrier_post(unsigned* bar, volatile LAS unsigned* st) {
    XcdBarrier b; b.bar = bar; b.x = xb_xcc_id(); b.st = st;
    if (threadIdx.x == 0) (void)xb_add(&bar[XB_XCNT(b.x)], 1u);
    return b;
}
__device__ __forceinline__ void xcd_barrier_complete(unsigned* bar, unsigned x, unsigned& nloc, unsigned& nx) {
    const unsigned G = gridDim.x * gridDim.y * gridDim.z;
    unsigned sum, cnt, mine, sp = 0u;
    for (;;) {
        sum = 0u; cnt = 0u; mine = 0u;
#pragma unroll
        for (unsigned j = 0; j < 16; ++j) { const unsigned c = xb_ld(&bar[XB_XCNT(j)]); sum += c; cnt += (c > 0u) ? 1u : 0u; mine = (j == x) ? c : mine; }
        if (sum == G) break;
        __builtin_amdgcn_s_sleep(1);
        if ((++sp & 255u) == 0u) { if (xb_ld(&bar[XB_TMO])) break; if (sp > XB_SPIN_CAP) { atomicAdd(&bar[XB_TMO], 1u); break; } }
    }
    nloc = mine > 0u ? mine : 1u; nx = cnt > 0u ? cnt : 1u;
}
__device__ __forceinline__ void xcd_barrier(const XcdBarrier& b) {
    asm volatile("s_waitcnt vmcnt(0)" ::: "memory");
    __syncthreads();
    if (threadIdx.x == 0) {
        unsigned* bar = b.bar;
        __builtin_amdgcn_s_waitcnt(0);
        unsigned nloc = b.st[0], nx = b.st[1];
        if (nloc == 0u) { xcd_barrier_complete(bar, b.x, nloc, nx); b.st[0] = nloc; b.st[1] = nx; }
        const unsigned old = xb_add(&bar[XB_XSUB(b.x)], 1u);
        const unsigned gen = old / nloc;
        if (old + 1u == (gen + 1u) * nloc) {
            __builtin_amdgcn_fence(__ATOMIC_RELEASE, "agent");
            asm volatile("s_waitcnt vmcnt(0)" ::: "memory");
            const unsigned og = xb_add(&bar[XB_TOP], 1u);
            const unsigned tg = og / nx;
            if (og + 1u == (tg + 1u) * nx) xb_add(&bar[XB_TOPGEN], 1u);
            else XB_SPIN(xb_ld(&bar[XB_TOPGEN]) == tg, bar);
            __builtin_amdgcn_fence(__ATOMIC_ACQUIRE, "agent");
            xb_add(&bar[XB_XGEN(b.x)], 1u);
            asm volatile("s_waitcnt vmcnt(0)" ::: "memory");
        } else {
            XB_SPIN(xb_ld(&bar[XB_XGEN(b.x)]) == gen, bar);
            __builtin_amdgcn_fence(__ATOMIC_ACQUIRE, "agent");
            asm volatile("s_waitcnt vmcnt(0)" ::: "memory");
        }
    }
    __syncthreads();
}

constexpr int BM = 256, BK = 64, HALF = 128, HTB = HALF * BK * 2, NXCD = 8, WGM = 4;
__device__ __forceinline__ int lds_byte(int r, int c) { const int st = (r >> 4) * 2 + (c >> 5), rr = r & 15, cc = c & 31, ob = rr * 64 + cc * 2; return st * 1024 + (ob ^ (((ob >> 9) & 1) << 5)); }
__device__ __forceinline__ void stage_rc(int b, int& R, int& C) { const int st = b / 1024, sb = b % 1024, swz = sb ^ (((sb >> 9) & 1) << 5); R = (st >> 1) * 16 + swz / 64; C = (st & 1) * 32 + (swz % 64) / 2; }
__device__ __forceinline__ int perm32(int rho) { const int n = rho >> 4, i = rho & 15; return 8 * (i >> 2) + 4 * n + (i & 3); }

enum { M_P1 = 0, M_BF16 = 1, M_GATE = 2, M_YSET = 3, M_YADD = 4, M_RES = 5, M_UPC = 6 };
struct GD {
    const bf16_t* A; const bf16_t* Bt; int lda, ldb, K, nM, nN, row0, mode, splitk;
    bf16_t* out; int ldc; const bf16_t* aux;
    const float* gm; const float* xin_lat; const float* xin_ctx; float* xout_lat; float* xout_ctx;
    const float* rope; const float* cw;
    int sctx, xctx; bf16_t* auxc;
};
struct Unit { int pm, pn, k0; };
constexpr int SK_S = 11, SK_NT = 4;
__device__ __forceinline__ bool unit_next(const GD& g, int i, Unit& u) {
    int nM = g.nM; const int nN = g.nN;
    const long L = (long)i * gridDim.x + blockIdx.x;
    u.k0 = 0;
    if (g.splitk) {
        if (L >= 16 * SK_S) return false;
        const int tile = (int)(L / SK_S), ks = (int)(L % SK_S); u.pm = 64 + (tile >> 2); u.pn = tile & 3; u.k0 = ks * SK_NT; return true;
    }
    if (g.sctx) {
        nM = 64;
        const long nb = (long)nM * nN;
        if (L >= nb) { const int sidx = (int)(L - nb), wN = nN + g.xctx; if (sidx >= 4 * wN) return false; u.pm = 64 + sidx / wN; u.pn = sidx % wN; return true; }
    }
    const int nwg = nM * nN;
    if (L >= nwg) return false;
    int wgid = (int)L; { const int q = nwg / NXCD, r = nwg % NXCD, xcd = wgid % NXCD, off = wgid / NXCD; wgid = (xcd < r ? xcd * (q + 1) : r * (q + 1) + (xcd - r) * q) + off; }
    const int nig = WGM * nN, gid = wgid / nig, fm = gid * WGM, gsz = (nM - fm) < WGM ? (nM - fm) : WGM;
    u.pm = fm + ((wgid % nig) % gsz); u.pn = (wgid % nig) / gsz; return true;
}

#ifndef MB
#define MB 1
#endif
#ifndef MBR
#define MBR 4
#endif
#ifndef MBG
#define MBG 4
#endif
#define GAS __attribute__((address_space(1)))
__device__ __forceinline__ unsigned char* lds_params_ws(LAS unsigned char* lds) { return ((LAS const Params*)(lds + PRM_OFF))->ws; }
template <class T> __device__ __forceinline__ GAS T* gptr(T* q) { return (GAS T*)(unsigned long long)uptr(q); }
__device__ __forceinline__ void gemm_epilogue(LAS unsigned char* lds, const GD& gd, const f32x4 (&acc)[2][2][4][2], const Unit& u) {
    const int tid_e = otid(), wid_e = __builtin_amdgcn_readfirstlane(tid_e >> 6), wr = wid_e >> 2, wc = wid_e & 3, fr = tid_e & 15, fq = (tid_e >> 4) & 3;
    const int mode = __builtin_amdgcn_readfirstlane(gd.mode);
    const int row_u = __builtin_amdgcn_readfirstlane(gd.row0) + u.pm * BM;
    const int lrow = wr * 64 + fr;
    if (mode == M_UPC) {
        const int chl = wc * 32 + 8 * fq;
        GAS const float* cwu = gptr(gd.cw + u.pn * 128);
        f32x4 cwv[2][3], cwg[2][3];
#pragma unroll
        for (int n = 0; n < 2; ++n)
#pragma unroll
            for (int tp = 0; tp < 3; ++tp) { cwv[n][tp] = *(GAS const f32x4*)(cwu + tp * 5632 + chl + 4 * n); cwg[n][tp] = *(GAS const f32x4*)(cwu + tp * 5632 + DFF + chl + 4 * n); }
        asm volatile("" ::: "memory");
        LAS float* EX = (LAS float*)(lds + 131072);
#define EXI(ai_, wr_, tb_) ((((((ai_) * 2 + (wr_)) * 4 + wc) * 2 + (tb_)) * 4 + fq) * 16)
#pragma unroll
        for (int ai = 0; ai < 2; ++ai)
#pragma unroll
            for (int bj = 0; bj < 2; ++bj)
#pragma unroll
                for (int n = 0; n < 2; ++n) {
                    if (fr == 0) *(LAS f32x4*)(EX + EXI(ai, wr, 0) + bj * 8 + n * 4) = acc[ai][bj][0][n];
                    if (fr == 15) *(LAS f32x4*)(EX + EXI(ai, wr, 1) + bj * 8 + n * 4) = acc[ai][bj][3][n];
                }
        {
            GAS bf16_t* HB = gptr((bf16_t*)gd.aux + (size_t)u.pm * 4 * 5632 + u.pn * 256) + wc * 32 + 8 * fq;
            if (wr == 0 && fr == 0) {
#pragma unroll
                for (int mm = 0; mm < 2; ++mm)
#pragma unroll
                    for (int bj = 0; bj < 2; ++bj) { const f32x4 v0 = acc[0][bj][mm][0], v1 = acc[0][bj][mm][1];
                        u32x4 w; w.x = pk2(v0[0], v0[1]); w.y = pk2(v0[2], v0[3]); w.z = pk2(v1[0], v1[1]); w.w = pk2(v1[2], v1[3]);
                        *(GAS u32x4*)(HB + mm * 5632 + bj * HALF) = w; }
            }
            if (wr == 1 && fr == 15) {
#pragma unroll
                for (int mm = 2; mm < 4; ++mm)
#pragma unroll
                    for (int bj = 0; bj < 2; ++bj) { const f32x4 v0 = acc[1][bj][mm][0], v1 = acc[1][bj][mm][1];
                        u32x4 w; w.x = pk2(v0[0], v0[1]); w.y = pk2(v0[2], v0[3]); w.z = pk2(v1[0], v1[1]); w.w = pk2(v1[2], v1[3]);
                        *(GAS u32x4*)(HB + mm * 5632 + bj * HALF) = w; }
            }
        }
        asm volatile("s_waitcnt lgkmcnt(0)" ::: "memory");
        __builtin_amdgcn_s_barrier();
        __builtin_amdgcn_s_barrier();
        asm volatile("" ::: "memory");
        GAS bf16_t* outu = gptr(gd.out + (size_t)row_u * DFF + u.pn * 128);
        const unsigned ooff = (unsigned)((wr * 64 + 4 * fr) * DFF + chl);
#pragma unroll
        for (int ai = 0; ai < 2; ++ai) {
            const bool has_prev = !(ai == 0 && wr == 0), has_next = !(ai == 1 && wr == 1);
            const int pa = wr ? ai : ai - 1, pw = wr ? 0 : 1, na = wr ? ai + 1 : ai, nw = wr ? 0 : 1;
            unsigned actw[4][4];
#pragma unroll
            for (int n = 0; n < 2; ++n) {
                f32x4 ep[2], en[2];
#pragma unroll
                for (int bj = 0; bj < 2; ++bj) {
                    ep[bj] = has_prev ? *(const LAS f32x4*)(EX + EXI(pa, pw, 1) + bj * 8 + n * 4) : (f32x4){0.f, 0.f, 0.f, 0.f};
                    en[bj] = has_next ? *(const LAS f32x4*)(EX + EXI(na, nw, 0) + bj * 8 + n * 4) : (f32x4){0.f, 0.f, 0.f, 0.f};
                }
#pragma unroll
                for (int jp = 0; jp < 2; ++jp) {
                    f32x2 cv[2][4];
#pragma unroll
                    for (int bj = 0; bj < 2; ++bj) {
                        const f32x4 W0 = bj ? cwg[n][0] : cwv[n][0], W1 = bj ? cwg[n][1] : cwv[n][1], W2 = bj ? cwg[n][2] : cwv[n][2];
                        f32x2 w0, w1, w2;
                        w0.x = W0[2 * jp]; w0.y = W0[2 * jp + 1]; w1.x = W1[2 * jp]; w1.y = W1[2 * jp + 1]; w2.x = W2[2 * jp]; w2.y = W2[2 * jp + 1];
                        f32x2 cur[4];
#pragma unroll
                        for (int m = 0; m < 4; ++m) { cur[m].x = acc[ai][bj][m][n][2 * jp]; cur[m].y = acc[ai][bj][m][n][2 * jp + 1]; }
                        float pvx = __builtin_bit_cast(float, __builtin_amdgcn_update_dpp(0, __builtin_bit_cast(int, (float)cur[3].x), 0x121, 0xF, 0xF, false));
                        float pvy = __builtin_bit_cast(float, __builtin_amdgcn_update_dpp(0, __builtin_bit_cast(int, (float)cur[3].y), 0x121, 0xF, 0xF, false));
                        float nxx = __builtin_bit_cast(float, __builtin_amdgcn_update_dpp(0, __builtin_bit_cast(int, (float)cur[0].x), 0x12F, 0xF, 0xF, false));
                        float nxy = __builtin_bit_cast(float, __builtin_amdgcn_update_dpp(0, __builtin_bit_cast(int, (float)cur[0].y), 0x12F, 0xF, 0xF, false));
                        pvx = (fr == 0) ? ep[bj][2 * jp] : pvx; pvy = (fr == 0) ? ep[bj][2 * jp + 1] : pvy;
                        nxx = (fr == 15) ? en[bj][2 * jp] : nxx; nxy = (fr == 15) ? en[bj][2 * jp + 1] : nxy;
                        f32x2 above, below; above.x = pvx; above.y = pvy; below.x = nxx; below.y = nxy;
#pragma unroll
                        for (int m = 0; m < 4; ++m) {
                            const f32x2 pv = (m == 0) ? above : cur[m > 0 ? m - 1 : 0];
                            const f32x2 nx = (m == 3) ? below : cur[m < 3 ? m + 1 : 3];
                            cv[bj][m] = w0 * pv + w1 * cur[m] + w2 * nx;
                        }
                    }
#pragma unroll
                    for (int m = 0; m < 4; ++m) {
                        const f32x2 gq = cv[1][m];
                        f32x2 sg; sg.x = fast_sigmoid(gq.x); sg.y = fast_sigmoid(gq.y);
                        const f32x2 a2 = cv[0][m] * gq * sg;
                        actw[m][2 * n + jp] = pk2(a2.x, a2.y);
                    }
                }
            }
#pragma unroll
            for (int m = 0; m < 4; ++m) {
                u32x4 o; o.x = actw[m][0]; o.y = actw[m][1]; o.z = actw[m][2]; o.w = actw[m][3];
                *(GAS u32x4*)(outu + ooff + (ai * HALF + m) * DFF) = o;
            }
        }
#undef EXI
        return;
    }
    if (mode == M_RES) {
        const bool lat = row_u < NL;
        const int rb = lat ? (row_u >> 12) : 4;
        GAS const float* gmr = gptr(gd.gm + rb * 6144 + u.pn * BM);
        GAS const float* xin = gptr((lat ? gd.xin_lat : gd.xin_ctx - (size_t)NL * DM) + (size_t)row_u * DM + u.pn * BM);
        GAS float* xout = gptr((lat ? gd.xout_lat : gd.xout_ctx - (size_t)NL * DM) + (size_t)row_u * DM + u.pn * BM);
        const int lcol = wc * 32 + 4 * fq;
        const unsigned xoff = (unsigned)(lrow * DM + lcol);
        f32x4 gv[2][2];
#pragma unroll
        for (int bj = 0; bj < 2; ++bj)
#pragma unroll
            for (int n = 0; n < 2; ++n) gv[bj][n] = *(GAS const f32x4*)(gmr + lcol + bj * HALF + n * 16);
        if (gd.splitk) {
            GAS float* part = gptr((float*)(lds_params_ws(lds) + OFF_PART) + ((size_t)(u.k0 / SK_NT) * 1024 + (row_u - NL)) * DM + u.pn * BM);
#pragma unroll
            for (int ai = 0; ai < 2; ++ai)
#pragma unroll
                for (int m = 0; m < 4; ++m)
#pragma unroll
                    for (int bj = 0; bj < 2; ++bj)
#pragma unroll
                        for (int n = 0; n < 2; ++n) *(GAS f32x4*)(part + xoff + (ai * HALF + m * 16) * DM + bj * HALF + n * 16) = gv[bj][n] * acc[ai][bj][m][n];
            return;
        }
#pragma unroll
        for (int am = 0; am < 8 / MBR; ++am) {
            const int ai = (am * MBR) >> 2, m0 = (am * MBR) & 3;
            f32x4 xi[MBR][2][2];
#pragma unroll
            for (int mm = 0; mm < MBR; ++mm)
#pragma unroll
                for (int bj = 0; bj < 2; ++bj)
#pragma unroll
                    for (int n = 0; n < 2; ++n) xi[mm][bj][n] = *(GAS const f32x4*)(xin + xoff + (ai * HALF + (m0 + mm) * 16) * DM + bj * HALF + n * 16);
            asm volatile("" ::: "memory");
#pragma unroll
            for (int mm = 0; mm < MBR; ++mm)
#pragma unroll
                for (int bj = 0; bj < 2; ++bj)
#pragma unroll
                    for (int n = 0; n < 2; ++n) *(GAS f32x4*)(xout + xoff + (ai * HALF + (m0 + mm) * 16) * DM + bj * HALF + n * 16) = xi[mm][bj][n] + gv[bj][n] * acc[ai][bj][m0 + mm][n];
        }
        return;
    }
    int ldc = __builtin_amdgcn_readfirstlane(gd.ldc);
    const int lcol = wc * 32 + 8 * fq;
    const bool ctx_gate_out = (mode == M_P1) && (u.pn >= 5);
    const bool ctx_gate_in = (row_u >= NL) && (gd.auxc != nullptr);
    const int emode = ctx_gate_out ? (int)M_GATE : mode;
    if (ctx_gate_out) ldc = 3072;
    const int apitch = ctx_gate_in ? 3072 : 1024;
    GAS bf16_t* outu = gptr(ctx_gate_out ? gd.auxc + (size_t)(row_u - NL) * 3072 + (u.pn - 5) * BM : gd.out + (size_t)row_u * ldc + u.pn * BM);
    GAS const bf16_t* auxu = gptr(ctx_gate_in ? (const bf16_t*)gd.auxc + (size_t)(row_u - NL) * 3072 + u.pn * BM : gd.aux + (size_t)row_u * 1024 + u.pn * BM);
    const unsigned ooff = (unsigned)(lrow * ldc + lcol), goff = (unsigned)(lrow * apitch + lcol);
    if (mode == M_YSET || mode == M_YADD) {
#pragma unroll
        for (int am = 0; am < 8 / MBG; ++am) {
            const int ai = (am * MBG) >> 2, m0 = (am * MBG) & 3;
            u32x4 gw[MBG][2], yw[MBG][2];
#pragma unroll
            for (int mm = 0; mm < MBG; ++mm)
#pragma unroll
                for (int bj = 0; bj < 2; ++bj) {
                    const int ro = ai * HALF + (m0 + mm) * 16;
                    gw[mm][bj] = *(GAS const u32x4*)(auxu + goff + ro * apitch + bj * HALF);
                    if (mode == M_YADD) yw[mm][bj] = *(GAS const u32x4*)(outu + ooff + ro * ldc + bj * HALF);
                }
            asm volatile("" ::: "memory");
#pragma unroll
            for (int mm = 0; mm < MBG; ++mm) {
                const int m = m0 + mm;
#pragma unroll
                for (int bj = 0; bj < 2; ++bj) {
                    f32x4 v0 = acc[ai][bj][m][0], v1 = acc[ai][bj][m][1];
                    const u32x4 q = gw[mm][bj];
                    v0[0] *= bflo(q.x); v0[1] *= bfhi(q.x); v0[2] *= bflo(q.y); v0[3] *= bfhi(q.y);
                    v1[0] *= bflo(q.z); v1[1] *= bfhi(q.z); v1[2] *= bflo(q.w); v1[3] *= bfhi(q.w);
                    if (mode == M_YADD) {
                        const u32x4 y = yw[mm][bj];
                        v0[0] += bflo(y.x); v0[1] += bfhi(y.x); v0[2] += bflo(y.y); v0[3] += bfhi(y.y);
                        v1[0] += bflo(y.z); v1[1] += bfhi(y.z); v1[2] += bflo(y.w); v1[3] += bfhi(y.w);
                    }
                    u32x4 w; w.x = pk2(v0[0], v0[1]); w.y = pk2(v0[2], v0[3]); w.z = pk2(v1[0], v1[1]); w.w = pk2(v1[2], v1[3]);
                    *(GAS u32x4*)(outu + ooff + (ai * HALF + m * 16) * ldc + bj * HALF) = w;
                }
            }
        }
        return;
    }
    const bool rope_unit = (mode == M_P1) && (row_u < NL) && (u.pn <= 2);
#pragma unroll
    for (int am = 0; am < 8; ++am) {
        const int ai = am >> 2, m = am & 3;
        f32x4 cs[4];
        if (rope_unit) {
            const int row = row_u + lrow + ai * HALF + m * 16;
            const int t = row & 4095, pos = (wc & 1) ? (t & 63) : (t >> 6);
            const LAS f32x4* cp = (const LAS f32x4*)(lds + 139264 + (pos * 16 + 8 * (fq & 1)) * 8);
#pragma unroll
            for (int q = 0; q < 4; ++q) cs[q] = cp[q];
        }
#pragma unroll
        for (int bj = 0; bj < 2; ++bj) {
            f32x4 v0 = acc[ai][bj][m][0], v1 = acc[ai][bj][m][1];
            if (rope_unit && !(u.pn == 0 && bj == 1)) {
                const float sg = (fq < 2) ? -1.f : 1.f;
#pragma unroll
                for (int j = 0; j < 4; ++j) {
                    const float p0 = xor32(v0[j], fq >= 2), p1 = xor32(v1[j], fq >= 2);
                    const float c0 = cs[j >> 1][(j & 1) * 2], s0 = cs[j >> 1][(j & 1) * 2 + 1];
                    const float c1 = cs[2 + (j >> 1)][(j & 1) * 2], s1 = cs[2 + (j >> 1)][(j & 1) * 2 + 1];
                    v0[j] = v0[j] * c0 + sg * p0 * s0; v1[j] = v1[j] * c1 + sg * p1 * s1;
                }
            }
            if (emode == M_GATE) {
#pragma unroll
                for (int j = 0; j < 4; ++j) { v0[j] = fast_sigmoid(v0[j]); v1[j] = fast_sigmoid(v1[j]); }
            }
            u32x4 w; w.x = pk2(v0[0], v0[1]); w.y = pk2(v0[2], v0[3]); w.z = pk2(v1[0], v1[1]); w.w = pk2(v1[2], v1[3]);
            *(GAS u32x4*)(outu + ooff + (ai * HALF + m * 16) * ldc + bj * HALF) = w;
        }
    }
}

__device__ __forceinline__ void fixup_tile(const bf16_t* HBp, bf16_t* ACTp, const float* cwp, int pm) {
    const int tid = otid();
    if (pm >= 64 || tid >= 352) return;
    GAS const bf16_t* HB = (GAS const bf16_t*)(unsigned long long)HBp;
    GAS bf16_t* ACT = (GAS bf16_t*)(unsigned long long)ACTp;
    GAS const float* cw = (GAS const float*)(unsigned long long)cwp;
    const int ch = tid * 8, col = 256 * (ch >> 7) + (ch & 127);
    const bool up_nb = (pm & 15) != 0, dn_nb = (pm & 15) != 15;
    const u32x4 z = {0u, 0u, 0u, 0u};
    GAS const bf16_t* h0 = HB + (size_t)pm * 4 * 5632 + col;
    u32x4 rv[6], rg[6];
    rv[0] = up_nb ? *(GAS const u32x4*)(h0 - 5632) : z;          rg[0] = up_nb ? *(GAS const u32x4*)(h0 - 5632 + 128) : z;
    rv[1] = *(GAS const u32x4*)(h0);                              rg[1] = *(GAS const u32x4*)(h0 + 128);
    rv[2] = *(GAS const u32x4*)(h0 + 5632);                       rg[2] = *(GAS const u32x4*)(h0 + 5632 + 128);
    rv[3] = *(GAS const u32x4*)(h0 + 2 * 5632);                   rg[3] = *(GAS const u32x4*)(h0 + 2 * 5632 + 128);
    rv[4] = *(GAS const u32x4*)(h0 + 3 * 5632);                   rg[4] = *(GAS const u32x4*)(h0 + 3 * 5632 + 128);
    rv[5] = dn_nb ? *(GAS const u32x4*)(h0 + 4 * 5632) : z;      rg[5] = dn_nb ? *(GAS const u32x4*)(h0 + 4 * 5632 + 128) : z;
    float wv[3][8], wg[3][8];
#pragma unroll
    for (int t = 0; t < 3; ++t) {
        const f32x4 a0 = *(GAS const f32x4*)(cw + t * 5632 + ch), a1 = *(GAS const f32x4*)(cw + t * 5632 + ch + 4);
        const f32x4 b0 = *(GAS const f32x4*)(cw + t * 5632 + DFF + ch), b1 = *(GAS const f32x4*)(cw + t * 5632 + DFF + ch + 4);
#pragma unroll
        for (int q = 0; q < 4; ++q) { wv[t][q] = a0[q]; wv[t][4 + q] = a1[q]; wg[t][q] = b0[q]; wg[t][4 + q] = b1[q]; }
    }
    asm volatile("" ::: "memory");
#pragma unroll
    for (int r = 0; r < 2; ++r) {
        if (r == 0 ? !up_nb : !dn_nb) continue;
        float a[8];
#pragma unroll
        for (int q = 0; q < 8; ++q) {
            const int w = q >> 1;
            float v[3], gq[3];
#pragma unroll
            for (int t = 0; t < 3; ++t) {
                const unsigned uv = rv[3 * r + t][w], ug = rg[3 * r + t][w];
                v[t] = (q & 1) ? bfhi(uv) : bflo(uv); gq[t] = (q & 1) ? bfhi(ug) : bflo(ug);
            }
            const float cvv = wv[0][q] * v[0] + wv[1][q] * v[1] + wv[2][q] * v[2];
            const float cg = wg[0][q] * gq[0] + wg[1][q] * gq[1] + wg[2][q] * gq[2];
            a[q] = cvv * cg * fast_sigmoid(cg);
        }
        u32x4 o; o.x = pk2(a[0], a[1]); o.y = pk2(a[2], a[3]); o.z = pk2(a[4], a[5]); o.w = pk2(a[6], a[7]);
        *(GAS u32x4*)(ACT + (size_t)(256 * pm + (r ? 255 : 0)) * DFF + ch) = o;
    }
}

__device__ __forceinline__ bool make_gd(LAS const Params* lp, int l, int sub, int gi, GD& g) {
    Params p; p.ws = lp->ws; p.out = lp->out; p.x = lp->x; p.ctx = lp->ctx;
    unsigned char* ws = p.ws;
    const unsigned char* wb = ws + OFF_W + (size_t)l * LW;
    const bf16_t* WinT = (const bf16_t*)(wb + LW_WIN); const bf16_t* WmT = (const bf16_t*)(wb + LW_WM); const bf16_t* WoT = (const bf16_t*)(wb + LW_WO);
    const bf16_t* WupT = (const bf16_t*)(wb + LW_WUP); const bf16_t* WdT = (const bf16_t*)(wb + LW_WD);
    const bf16_t* H = (const bf16_t*)(ws + OFF_H);
    bf16_t* P1 = (bf16_t*)(ws + OFF_P1); bf16_t* AM = (bf16_t*)(ws + OFF_AM); bf16_t* YM = (bf16_t*)(ws + OFF_YM);
    const float* mod = (const float*)(ws + OFF_MOD) + (size_t)l * 5 * 6144;
    const int mt = (l == 0) ? 68 : 64;
    g.row0 = 0; g.splitk = 0; g.sctx = 0; g.xctx = 0; g.auxc = nullptr; g.aux = P1; g.gm = mod; g.rope = (const float*)(ws + OFF_ROPE);
    g.xin_lat = p.out; g.xin_ctx = (const float*)(ws + OFF_XC); g.xout_lat = p.out; g.xout_ctx = (float*)(ws + OFF_XC);
    g.out = P1; g.ldc = 1024; g.lda = 1024; g.ldb = 1024; g.K = 1024;
    switch (sub) {
    case 1:
        if (gi) return false;
        g.A = H; g.Bt = WinT; g.nM = 68; g.nN = 5; g.mode = M_P1; g.ldc = P1LD;
        if (l == 0) { g.sctx = 1; g.xctx = 12; g.auxc = (bf16_t*)(ws + OFF_GC); }
        return true;
    case 3:
        g.nM = mt; g.nN = 4;
        if (gi == 0 || gi == 2 || gi == 4) { g.A = H; g.Bt = WinT + (size_t)(1280 + 512 * gi) * 1024; g.mode = M_GATE; g.out = P1; g.nM = 64; return true; }
        if (l == 0) { g.sctx = 1; g.auxc = (bf16_t*)(ws + OFF_GC) + ((gi - 1) >> 1) * 1024; }
        g.out = YM; g.lda = 1280; g.ldb = 1280;
        if (gi == 1) { g.A = AM; g.Bt = WmT; g.K = 512; g.mode = M_YSET; return true; }
        if (gi == 3) { g.A = AM + 512; g.Bt = WmT + 512; g.K = 256; g.mode = M_YADD; return true; }
        if (gi == 5) { g.A = AM + 768; g.Bt = WmT + 768; g.K = 512; g.mode = M_YADD; return true; }
        return false;
    case 4:
        if (gi) return false;
        g.A = YM; g.Bt = WoT; g.nM = mt; g.nN = 4; g.mode = M_RES; g.gm = mod + 2048;
        if (l == 0) { g.xin_lat = p.x; g.xin_ctx = p.ctx; }
        return true;
    case 6:
        if (gi) return false;
        g.A = H; g.Bt = WupT; g.nM = mt; g.nN = 22; g.mode = M_UPC; g.out = (bf16_t*)(ws + OFF_ACT); g.ldc = DFF; g.aux = (const bf16_t*)(ws + OFF_HB);
        g.cw = lp->conv_w + (size_t)l * 3 * 5632;
        return true;
    case 8:
        if (gi > 1 || (gi == 1 && l != 0)) return false;
        g.A = (const bf16_t*)(ws + OFF_ACT); g.lda = DFF; g.Bt = WdT; g.ldb = DFF; g.K = DFF; g.nM = 64; g.nN = 4; g.mode = M_RES; g.gm = mod + 5120;
        if (gi == 1) { g.splitk = 1; g.K = SK_NT * BK; }
        return true;
    }
    return false;
}


__device__ __forceinline__ bool gemm_phase(LAS unsigned char* lds, int l, int sub, int gi, bool dry = false) {
    GD g; if (!make_gd((LAS const Params*)(lds + PRM_OFF), l, sub, gi, g)) return false;
    g.A = uptr(g.A); g.Bt = uptr(g.Bt); g.lda = __builtin_amdgcn_readfirstlane(g.lda); g.ldb = __builtin_amdgcn_readfirstlane(g.ldb); g.K = __builtin_amdgcn_readfirstlane(g.K);
    g.nM = __builtin_amdgcn_readfirstlane(g.nM); g.splitk = __builtin_amdgcn_readfirstlane(g.splitk); g.xctx = __builtin_amdgcn_readfirstlane(g.xctx); g.sctx = __builtin_amdgcn_readfirstlane(g.sctx); g.nN = __builtin_amdgcn_readfirstlane(g.nN); g.mode = __builtin_amdgcn_readfirstlane(g.mode);
    if (sub == 1) {
        GAS const u32x4* rt = (GAS const u32x4*)(unsigned long long)(((LAS const Params*)(lds + PRM_OFF))->ws + OFF_ROPE);
        const int t0 = otid();
        *(LAS u32x4*)(lds + 139264 + t0 * 16) = rt[t0];
    }
    if (sub == 8) {
        LAS const Params* lp = (LAS const Params*)(lds + PRM_OFF);
        unsigned char* ws = lp->ws; const float* cwp = lp->conv_w + (size_t)l * 3 * 5632;
        Unit fu;
        for (int i = 0; unit_next(g, i, fu); ++i) fixup_tile((const bf16_t*)(ws + OFF_HB), (bf16_t*)(ws + OFF_ACT), cwp, fu.pm);
        asm volatile("s_waitcnt vmcnt(0)" ::: "memory");
        __syncthreads();
    }
    const int tid = otid(), wid = __builtin_amdgcn_readfirstlane(tid >> 6), lane = tid & 63, wr = wid >> 2, wc = wid & 3, fr = lane & 15, fq = lane >> 4;
    const int K = g.K, nt = K / BK;
    const bool perm = (g.mode != M_RES);
    unsigned voffA[2], voffB[2];
#pragma unroll
    for (int i = 0; i < 2; ++i) { int R, C; stage_rc(tid * 16 + i * 8192, R, C); const int Rb = perm ? ((R & ~31) + perm32(R & 31)) : R;
        const int Ra = (g.mode == M_UPC) ? ((R & ~63) + 4 * (R & 15) + ((R >> 4) & 3)) : R;
        voffA[i] = (unsigned)(Ra * g.lda + C) * 2u; voffB[i] = (unsigned)(Rb * g.ldb + C) * 2u; }
    const size_t kstep = (size_t)(BK * 2);
    const size_t hstepA = (size_t)HALF * g.lda * 2, hstepB = (size_t)HALF * g.ldb * 2;
    const size_t tstepA = 2 * hstepA, tstepB = 2 * hstepB;
    const unsigned ldsw = (unsigned)wid * 1024u;
    const int aoff = lds_byte(wr * 64 + fr, fq * 8), boff = lds_byte(wc * 32 + fr, fq * 8);
#define PG8_SA(b, h) (((b) * 2 + (h)) * HTB)
#define PG8_SB(b, h) ((4 + (b) * 2 + (h)) * HTB)
#define PG8_STAGE(bufoff, gbase, voff) do { _Pragma("unroll") for (int _i = 0; _i < 2; ++_i) \
        __builtin_amdgcn_global_load_lds((const unsigned*)((const char*)(gbase) + (voff)[_i]), (LAS unsigned*)(lds + (bufoff) + ldsw + _i * 8192), 16, 0, 0); } while (0)
#define PG8_LDA(dst, b, h) do { _Pragma("unroll") for (int m = 0; m < 4; ++m) _Pragma("unroll") for (int k = 0; k < 2; ++k) dst[m][k] = *(const LAS bf16x8*)(lds + PG8_SA(b, h) + aoff + m * 2048 + k * 1024); } while (0)
#define PG8_LDB(dst, b, h) do { _Pragma("unroll") for (int n = 0; n < 2; ++n) _Pragma("unroll") for (int k = 0; k < 2; ++k) dst[n][k] = *(const LAS bf16x8*)(lds + PG8_SB(b, h) + boff + n * 2048 + k * 1024); } while (0)
#define PG8_MMA(ai, bj, At, Bt) do { __builtin_amdgcn_s_setprio(1); _Pragma("unroll") for (int m = 0; m < 4; ++m) _Pragma("unroll") for (int n = 0; n < 2; ++n) _Pragma("unroll") for (int k = 0; k < 2; ++k) \
        acc[ai][bj][m][n] = __builtin_amdgcn_mfma_f32_16x16x32_bf16(Bt[n][k], At[m][k], acc[ai][bj][m][n], 0, 0, 0); __builtin_amdgcn_s_setprio(0); } while (0)
#define PG8_WAIT_V(n) asm volatile("s_waitcnt vmcnt(" #n ")" ::: "memory")
#define PG8_WAIT_L(n) asm volatile("s_waitcnt lgkmcnt(" #n ")" ::: "memory")
#define PG8_BAR __builtin_amdgcn_s_barrier()
#define PG8_SCHED __builtin_amdgcn_sched_barrier(0)
    Unit cur, nxt; int ui = 0;
    if (!unit_next(g, 0, cur)) return true;
    f32x4 acc[2][2][4][2];
#pragma unroll
    for (int a = 0; a < 2; ++a)
#pragma unroll
        for (int b = 0; b < 2; ++b)
#pragma unroll
            for (int m = 0; m < 4; ++m)
#pragma unroll
                for (int n = 0; n < 2; ++n) acc[a][b][m][n] = (f32x4){0.f, 0.f, 0.f, 0.f};
    bf16x8 At[4][2], B0[2][2], B1[2][2];
    const char* cA = (const char*)g.A + (size_t)cur.pm * tstepA + (size_t)cur.k0 * kstep; const char* cB = (const char*)g.Bt + (size_t)cur.pn * tstepB + (size_t)cur.k0 * kstep;
    PG8_STAGE(PG8_SB(0, 0), cB, voffB); PG8_STAGE(PG8_SA(0, 0), cA, voffA); PG8_STAGE(PG8_SB(0, 1), cB + hstepB, voffB); PG8_STAGE(PG8_SA(0, 1), cA + hstepA, voffA);
    if (wr == 1) PG8_BAR;
    PG8_WAIT_V(4); PG8_BAR;
    PG8_STAGE(PG8_SB(1, 0), cB + kstep, voffB); PG8_STAGE(PG8_SA(1, 0), cA + kstep, voffA); PG8_STAGE(PG8_SB(1, 1), cB + hstepB + kstep, voffB);
    PG8_WAIT_V(6); PG8_BAR;
    for (;;) {
        const bool has_next = unit_next(g, ui + 1, nxt);
        const char* nA = has_next ? (const char*)g.A + (size_t)nxt.pm * tstepA + (size_t)nxt.k0 * kstep : cA; const char* nB = has_next ? (const char*)g.Bt + (size_t)nxt.pn * tstepB + (size_t)nxt.k0 * kstep : cB;
        for (int t = 0; t < nt; t += 2) {
            const bool last = (t == nt - 2);
            const char* a1 = cA + (size_t)(t + 1) * kstep;
            const char* a2 = last ? nA : cA + (size_t)(t + 2) * kstep; const char* b2 = last ? nB : cB + (size_t)(t + 2) * kstep;
            const char* a3 = a2 + kstep; const char* b3 = b2 + kstep;
            PG8_LDB(B0, 0, 0); PG8_SCHED; PG8_LDA(At, 0, 0); PG8_STAGE(PG8_SA(1, 1), a1 + hstepA, voffA);
            PG8_WAIT_L(8); PG8_BAR; PG8_WAIT_L(0); PG8_MMA(0, 0, At, B0); PG8_BAR; PG8_SCHED;
            PG8_LDB(B1, 0, 1); PG8_STAGE(PG8_SB(0, 0), b2, voffB);
            PG8_BAR; PG8_WAIT_L(0); PG8_MMA(0, 1, At, B1); PG8_BAR;
            PG8_LDA(At, 0, 1); PG8_STAGE(PG8_SA(0, 0), a2, voffA);
            PG8_BAR; PG8_WAIT_L(0); PG8_MMA(1, 0, At, B0); PG8_BAR; PG8_SCHED;
            PG8_STAGE(PG8_SB(0, 1), b2 + hstepB, voffB);
            PG8_WAIT_V(6); PG8_BAR; PG8_MMA(1, 1, At, B1); PG8_BAR;
            PG8_LDB(B0, 1, 0); PG8_SCHED; PG8_LDA(At, 1, 0); PG8_STAGE(PG8_SA(0, 1), a2 + hstepA, voffA);
            PG8_WAIT_L(8); PG8_BAR; PG8_WAIT_L(0); PG8_MMA(0, 0, At, B0); PG8_BAR; PG8_SCHED;
            PG8_LDB(B1, 1, 1); PG8_STAGE(PG8_SB(1, 0), b3, voffB);
            PG8_BAR; PG8_WAIT_L(0); PG8_MMA(0, 1, At, B1); PG8_BAR;
            PG8_LDA(At, 1, 1); PG8_STAGE(PG8_SA(1, 0), a3, voffA);
            PG8_BAR; PG8_WAIT_L(0); PG8_MMA(1, 0, At, B0); PG8_BAR; PG8_SCHED;
            PG8_STAGE(PG8_SB(1, 1), b3 + hstepB, voffB);
            PG8_WAIT_V(6); PG8_BAR; PG8_MMA(1, 1, At, B1); PG8_BAR;
        }
        __builtin_amdgcn_sched_barrier(0); asm volatile("" ::: "memory");
        if (!dry) { GD g2; make_gd((LAS const Params*)(lds + PRM_OFF), l, sub, gi, g2); gemm_epilogue(lds, g2, acc, cur); }
        if (!has_next) break;
#pragma unroll
        for (int a = 0; a < 2; ++a)
#pragma unroll
            for (int b = 0; b < 2; ++b)
#pragma unroll
                for (int m = 0; m < 4; ++m)
#pragma unroll
                    for (int n = 0; n < 2; ++n) acc[a][b][m][n] = (f32x4){0.f, 0.f, 0.f, 0.f};
        cur = nxt; cA = nA; cB = nB; ++ui;
    }
    PG8_WAIT_V(0);
    if (wr == 0) PG8_BAR;
    PG8_BAR;
    return true;
#undef PG8_SA
#undef PG8_SB
#undef PG8_STAGE
#undef PG8_LDA
#undef PG8_LDB
#undef PG8_MMA
#undef PG8_WAIT_V
#undef PG8_WAIT_L
#undef PG8_BAR
#undef PG8_SCHED
}

__device__ __forceinline__ void transpose_tile(const float* W, int N, bf16_t* WT, int ldd, int kb, int nb, int upmap, LAS float* scr) {
    const int tid = otid(), k0 = kb * 64, n0 = nb * 256;
    GAS const float* src = (GAS const float*)(unsigned long long)W + (size_t)k0 * N + n0;
    float tv[32];
#pragma unroll
    for (int i = 0; i < 32; ++i) { const int kk = i * 2 + (tid >> 8), nn = tid & 255; tv[i] = src[(size_t)kk * N + nn]; }
    asm volatile("" ::: "memory");
#pragma unroll
    for (int i = 0; i < 32; ++i) { const int kk = i * 2 + (tid >> 8), nn = tid & 255; scr[kk * 257 + nn] = tv[i]; }
    __syncthreads();
    const int c = tid & 7;
    GAS bf16_t* dst = (GAS bf16_t*)(unsigned long long)WT;
#pragma unroll
    for (int q = 0; q < 4; ++q) {
        const int n = (tid >> 3) + 64 * q; const LAS float* sp = scr + (8 * c) * 257 + n;
        u32x4 o; o.x = pk2(sp[0], sp[257]); o.y = pk2(sp[514], sp[771]); o.z = pk2(sp[1028], sp[1285]); o.w = pk2(sp[1542], sp[1799]);
        int nd = n0 + n;
        if (upmap) { nd = (nd < DFF) ? (256 * (nd >> 7) + (nd & 127)) : (256 * ((nd - DFF) >> 7) + 128 + ((nd - DFF) & 127)); }
        *(GAS u32x4*)(dst + (size_t)nd * ldd + k0 + 8 * c) = o;
    }
    __syncthreads();
}

__device__ void phase_prep(const Params& p, LAS unsigned char* lds) {
    const int tid = otid();
    LAS float* scr = (LAS float*)lds;
    constexpr int T_IN = 16 * 17, T_BA = 8 * 4, T_WO = 16 * 4, T_UP = 16 * 22, T_DN = 44 * 4, T_L = T_IN + T_BA + T_WO + T_UP + T_DN;
    constexpr int I_TR = 2 * T_L, I_POOL = I_TR + 128, I_FOUR = I_POOL + 256, I_MOD = I_FOUR + 192, I_ALL = I_MOD + 1;
    for (int prep_rep = 0; prep_rep < ((PROBE >= 301 && PROBE <= 304) ? 2 : 1); ++prep_rep)
    for (int it = blockIdx.x; it < I_ALL; it += gridDim.x) {
#if PROBE >= 301 && PROBE <= 304
        if (prep_rep == 1) { const int cls = (it < I_TR) ? 301 : (it < I_FOUR) ? 302 : (it < I_MOD) ? 303 : 304; if (cls != PROBE) continue; }
#endif
        if (it < I_TR) {
            const int l = it / T_L; int j = it % T_L;
            unsigned char* wb = p.ws + OFF_W + (size_t)l * LW;
            if (j < T_IN) transpose_tile(p.w_in + (size_t)l * 1024 * INW, INW, (bf16_t*)(wb + LW_WIN), 1024, j / 17, j % 17, 0, scr);
            else if ((j -= T_IN) < T_BA) transpose_tile(p.w_br_attn + (size_t)l * 512 * 1024, 1024, (bf16_t*)(wb + LW_WM), 1280, j / 4, j % 4, 0, scr);
            else if ((j -= T_BA) < T_WO) transpose_tile(p.w_out + (size_t)l * 1024 * 1024, 1024, (bf16_t*)(wb + LW_WO), 1024, j / 4, j % 4, 0, scr);
            else if ((j -= T_WO) < T_UP) transpose_tile(p.w_up + (size_t)l * 1024 * 5632, 5632, (bf16_t*)(wb + LW_WUP), 1024, j / 22, j % 22, 1, scr);
            else { j -= T_UP; transpose_tile(p.w_down + (size_t)l * DFF * 1024, 1024, (bf16_t*)(wb + LW_WD), DFF, j / 4, j % 4, 0, scr); }
        } else if (it < I_POOL) {
            const int j = it - I_TR, l = j >> 6, g = (j >> 4) & 3, nb = j & 15;
            const int n = nb * 64 + (tid & 63), co = tid >> 6;
            const float* pw = p.pool_w + (size_t)l * 16384 + g * 4096 + (8 * co) * 64;
            const float* sc = p.pool_scale + l * 256 + g * 64;
            const float* wb = p.w_br_pool + (size_t)l * 256 * 1024 + (size_t)(g * 64) * 1024 + n;
            float a[8];
#pragma unroll
            for (int q = 0; q < 8; ++q) a[q] = 0.f;
#pragma unroll 1
            for (int d0 = 0; d0 < 64; d0 += 16) {
                float wv[16];
#pragma unroll
                for (int dd = 0; dd < 16; ++dd) wv[dd] = ((GAS const float*)(unsigned long long)wb)[(size_t)(d0 + dd) * 1024];
                asm volatile("" ::: "memory");
#pragma unroll
                for (int dd = 0; dd < 16; ++dd) { const float w = sc[d0 + dd] * wv[dd];
#pragma unroll
                    for (int q = 0; q < 8; ++q) a[q] += pw[q * 64 + d0 + dd] * w; }
            }
            bf16_t* dst = (bf16_t*)(p.ws + OFF_W + (size_t)l * LW + LW_WM) + (size_t)n * 1280 + 512 + g * 64 + 8 * co;
            u32x4 o; o.x = pk2(a[0], a[1]); o.y = pk2(a[2], a[3]); o.z = pk2(a[4], a[5]); o.w = pk2(a[6], a[7]);
            *(u32x4*)dst = o;
        } else if (it < I_FOUR) {
            const int j = it - I_POOL, l = j >> 7, g = (j >> 5) & 3, nb = (j >> 1) & 15, part = j & 1;
            if (tid < 64) { float sv, cv; sincospif((float)tid / 32.f, &sv, &cv); scr[tid] = part ? sv : cv; }
            __syncthreads();
            const int n = nb * 64 + (tid & 63), co = tid >> 6;
            const float* wb = p.w_br_four + (size_t)l * 256 * 1024 + (size_t)(g * 64) * 1024 + n;
            float a[8];
#pragma unroll
            for (int q = 0; q < 8; ++q) a[q] = 0.f;
#pragma unroll 1
            for (int m0 = 0; m0 < 64; m0 += 16) {
                float wv[16];
#pragma unroll
                for (int dd = 0; dd < 16; ++dd) wv[dd] = ((GAS const float*)(unsigned long long)wb)[(size_t)(m0 + dd) * 1024];
                asm volatile("" ::: "memory");
#pragma unroll
                for (int dd = 0; dd < 16; ++dd) { const int m = m0 + dd; const float w = wv[dd];
#pragma unroll
                    for (int q = 0; q < 8; ++q) a[q] += scr[(m * (8 * co + q)) & 63] * w; }
            }
            bf16_t* dst = (bf16_t*)(p.ws + OFF_W + (size_t)l * LW + LW_WM) + (size_t)n * 1280 + 768 + g * 128 + part * 64 + 8 * co;
            u32x4 o; o.x = pk2(a[0], a[1]); o.y = pk2(a[2], a[3]); o.z = pk2(a[4], a[5]); o.w = pk2(a[6], a[7]);
            *(u32x4*)dst = o;
            __syncthreads();
        } else if (it < I_MOD) {
            const int j = it - I_FOUR, l = j / 96, cb = j % 96;
            for (int i = tid; i < 5 * 1024; i += 512) { const int r = i >> 10, k = i & 1023; const float v = (r < 4) ? p.c[r * 1024 + k] : p.c_ctx[k]; scr[i] = v / (1.f + __expf(-v)); }
            __syncthreads();
            const int col = cb * 64 + (tid & 63), ks = tid >> 6;
            GAS const float* wm = (GAS const float*)(unsigned long long)p.w_mod + (size_t)l * 1024 * 6144 + col;
            float a0 = 0.f, a1 = 0.f, a2 = 0.f, a3 = 0.f, a4 = 0.f;
#pragma unroll 1
            for (int k0 = ks * 128; k0 < ks * 128 + 128; k0 += 32) {
                float wv[32];
#pragma unroll
                for (int q = 0; q < 32; ++q) wv[q] = wm[(size_t)(k0 + q) * 6144];
                asm volatile("" ::: "memory");
#pragma unroll
                for (int q = 0; q < 32; ++q) { const int k = k0 + q; const float w = wv[q];
                    a0 += scr[k] * w; a1 += scr[1024 + k] * w; a2 += scr[2048 + k] * w; a3 += scr[3072 + k] * w; a4 += scr[4096 + k] * w; }
            }
            __syncthreads();
            LAS float* part = scr + 5120;
            part[(ks * 5 + 0) * 64 + (tid & 63)] = a0; part[(ks * 5 + 1) * 64 + (tid & 63)] = a1; part[(ks * 5 + 2) * 64 + (tid & 63)] = a2;
            part[(ks * 5 + 3) * 64 + (tid & 63)] = a3; part[(ks * 5 + 4) * 64 + (tid & 63)] = a4;
            __syncthreads();
            if (tid < 320) { const int r = tid >> 6, cc = tid & 63; float s = p.b_mod[l * 6144 + cb * 64 + cc];
#pragma unroll
                for (int q = 0; q < 8; ++q) s += part[(q * 5 + r) * 64 + cc];
                ((float*)(p.ws + OFF_MOD))[(size_t)(l * 5 + r) * 6144 + cb * 64 + cc] = s; }
            __syncthreads();
        } else {
            float* rope = (float*)(p.ws + OFF_ROPE); float* tw = (float*)(p.ws + OFF_TW);
            for (int i = tid; i < 1024; i += 512) { const int pos = i >> 4, f = i & 15; const float inv = powf(10000.f, -(float)f / 16.f); const float ang = (float)pos * inv;
                rope[2 * i] = cosf(ang); rope[2 * i + 1] = sinf(ang); }
            for (int i = tid; i < 4095; i += 512) { const int sh = 31 - __clz(i + 1), half = 1 << sh, j = i + 1 - half; float sv, cv; sincospif((float)j / (float)half, &sv, &cv); tw[2 * i] = cv; tw[2 * i + 1] = sv; }
        }
    }
}

__device__ void phase_norm(const Params& p, int l, int which) {
    const int tid = otid(), lane = tid & 63, gw = blockIdx.x * 8 + (tid >> 6), nw = gridDim.x * 8;
    const int nrows = (l == 1 && which == 1) ? NL : NR;
    const bool first = (l == 0 && which == 0);
    GAS const f32x4* gn = (GAS const f32x4*)(unsigned long long)((which ? p.norm_ffn : p.norm_mix) + l * 1024);
    GAS const float* mod = (GAS const float*)(unsigned long long)(p.ws + OFF_MOD) + (size_t)l * 5 * 6144 + (which ? 3072 : 0);
    GAS bf16_t* H = (GAS bf16_t*)(unsigned long long)(p.ws + OFF_H);
    for (int row = gw; row < nrows; row += nw) {
        GAS const f32x4* xr; int rb;
        if (row < NL) { xr = (GAS const f32x4*)(unsigned long long)((first ? p.x : p.out) + (size_t)row * DM); rb = row >> 12; }
        else { xr = (GAS const f32x4*)(unsigned long long)((first ? p.ctx : (const float*)(p.ws + OFF_XC)) + (size_t)(row - NL) * DM); rb = 4; }
        GAS const f32x4* sh = (GAS const f32x4*)(mod + rb * 6144); GAS const f32x4* sc = (GAS const f32x4*)(mod + rb * 6144 + 1024);
        f32x4 v[4], g4[4], s4[4], h4[4];
#pragma unroll
        for (int j = 0; j < 4; ++j) { v[j] = xr[lane + 64 * j]; g4[j] = gn[lane + 64 * j]; s4[j] = sc[lane + 64 * j]; h4[j] = sh[lane + 64 * j]; }
        asm volatile("" ::: "memory");
        if (l == 1 && which == 0 && row >= NL) {
            GAS const f32x4* pp = (GAS const f32x4*)(unsigned long long)((const float*)(p.ws + OFF_PART) + (size_t)(row - NL) * DM);
#pragma unroll 1
            for (int ks = 0; ks < SK_S; ++ks) {
                f32x4 t[4];
#pragma unroll
                for (int j = 0; j < 4; ++j) t[j] = pp[(size_t)ks * (1024 * DM / 4) + lane + 64 * j];
                asm volatile("" ::: "memory");
#pragma unroll
                for (int j = 0; j < 4; ++j) v[j] += t[j];
            }
        }
        float s = 0.f;
#pragma unroll
        for (int j = 0; j < 4; ++j) s += (v[j].x * v[j].x + v[j].y * v[j].y) + (v[j].z * v[j].z + v[j].w * v[j].w);
        const float rstd = rsqrtf(wave_sum(s) * (1.f / 1024.f) + 1e-6f);
#pragma unroll
        for (int j = 0; j < 4; ++j) {
            const f32x4 y = v[j] * rstd * g4[j] * (s4[j] + 1.f) + h4[j];
            u32x2 o; o.x = pk2(y.x, y.y); o.y = pk2(y.z, y.w);
            ((GAS u32x2*)(H + (size_t)row * DM))[lane + 64 * j] = o;
        }
    }
}

__device__ void phase_final(const Params& p) {
    const int tid = otid(), lane = tid & 63, gw = blockIdx.x * 8 + (tid >> 6), nw = gridDim.x * 8;
    GAS const f32x4* gf = (GAS const f32x4*)(unsigned long long)p.norm_final;
    for (int row = gw; row < NL; row += nw) {
        GAS f32x4* xr = (GAS f32x4*)(unsigned long long)(p.out + (size_t)row * DM);
        f32x4 v[4], g4[4];
#pragma unroll
        for (int j = 0; j < 4; ++j) { v[j] = xr[lane + 64 * j]; g4[j] = gf[lane + 64 * j]; }
        asm volatile("" ::: "memory");
        float s = 0.f;
#pragma unroll
        for (int j = 0; j < 4; ++j) s += (v[j].x * v[j].x + v[j].y * v[j].y) + (v[j].z * v[j].z + v[j].w * v[j].w);
        const float rstd = rsqrtf(wave_sum(s) * (1.f / 1024.f) + 1e-6f);
#pragma unroll
        for (int j = 0; j < 4; ++j) xr[lane + 64 * j] = v[j] * rstd * g4[j];
    }
}

constexpr int KPITCH = 144, VPITCH = 272;
__device__ void attn_item(const Params& p, int l, int item, LAS unsigned char* lds) {
    const int tid = otid(), wid = __builtin_amdgcn_readfirstlane(tid >> 6), lane = tid & 63, l31 = lane & 31, hi = lane >> 5;
    const bool isctx = item >= 512;
    int b, n, h, hb, qrow0;
    if (!isctx) { b = item >> 7; n = (item >> 2) & 31; h = (item >> 1) & 1; hb = item & 1; qrow0 = b * 4096 + n * 128; }
    else { const int j = item - 512; b = j >> 3; n = (j >> 2) & 1; h = (j >> 1) & 1; hb = j & 1; qrow0 = NL + b * 256 + n * 128; }
    const bf16_t* P1 = (const bf16_t*)(p.ws + OFF_P1);
    bf16_t* AM = (bf16_t*)(p.ws + OFF_AM);
    LAS unsigned char* Kl = lds; LAS unsigned char* Vt = lds + 128 * KPITCH;
    const int g = wid >> 1, head = 4 * h + g, qq = 64 * hb + 32 * (wid & 1) + l31;
    bf16x8 qf[4];
#pragma unroll
    for (int ks = 0; ks < 4; ++ks) {
        const u32x4 w = *(const u32x4*)(P1 + (size_t)(qrow0 + qq) * P1LD + 256 + head * 64 + 16 * ks + 8 * hi);
        u32x4 o; o.x = pk2(bflo(w.x) * 0.125f, bfhi(w.x) * 0.125f); o.y = pk2(bflo(w.y) * 0.125f, bfhi(w.y) * 0.125f);
        o.z = pk2(bflo(w.z) * 0.125f, bfhi(w.z) * 0.125f); o.w = pk2(bflo(w.w) * 0.125f, bfhi(w.w) * 0.125f);
        qf[ks] = __builtin_bit_cast(bf16x8, o);
    }
    f32x16 ot[2];
    float mrun = -1e30f, lrun = 0.f;
#pragma unroll
    for (int dt = 0; dt < 2; ++dt)
#pragma unroll
        for (int r = 0; r < 16; ++r) ot[dt][r] = 0.f;
    GAS const bf16_t* P1g = (GAS const bf16_t*)(unsigned long long)P1;
    const int pr = tid & 63, vslab = tid >> 6;
#define ATT_NEXT(c_) ({ int _c = (c_) + 1; if (!isctx) { if (_c == 1 && n == 0) _c = 2; if (_c == 2 && n == 31) _c = 3; } _c; })
#define ATT_KBASE(c_) ((c_) == 0 ? qrow0 : (c_) == 1 ? qrow0 - 128 : (c_) == 2 ? qrow0 + 128 : NL + b * 256 + ((c_) - 3) * 128)
    u32x4 kw[2], w0, w1;
    {
        const int kb0 = ATT_KBASE(isctx ? 3 : 0);
#pragma unroll
        for (int i = 0; i < 2; ++i) { const int q = tid + 512 * i, key = q >> 3, slab = q & 7;
            kw[i] = *(GAS const u32x4*)(P1g + (size_t)(kb0 + key) * P1LD + 64 * h + 8 * slab); }
        w0 = *(GAS const u32x4*)(P1g + (size_t)(kb0 + 2 * pr) * P1LD + 128 + 64 * h + 8 * vslab);
        w1 = *(GAS const u32x4*)(P1g + (size_t)(kb0 + 2 * pr + 1) * P1LD + 128 + 64 * h + 8 * vslab);
    }
#pragma unroll 1
    for (int ci = isctx ? 3 : 0; ci < 5; ci = ATT_NEXT(ci)) {
        const int mask = (ci == 1) ? 1 : (ci == 2) ? 2 : 0;
        asm volatile("" ::: "memory");
        __syncthreads();
        {
#pragma unroll
            for (int i = 0; i < 2; ++i) { const int q = tid + 512 * i, key = q >> 3, slab = q & 7; *(LAS u32x4*)(Kl + key * KPITCH + 16 * slab) = kw[i]; }
            LAS unsigned char* vb = Vt + (8 * vslab) * VPITCH + 4 * pr;
            *(LAS unsigned*)(vb + 0 * VPITCH) = (w0.x & 0xffffu) | (w1.x << 16); *(LAS unsigned*)(vb + 1 * VPITCH) = (w0.x >> 16) | (w1.x & 0xffff0000u);
            *(LAS unsigned*)(vb + 2 * VPITCH) = (w0.y & 0xffffu) | (w1.y << 16); *(LAS unsigned*)(vb + 3 * VPITCH) = (w0.y >> 16) | (w1.y & 0xffff0000u);
            *(LAS unsigned*)(vb + 4 * VPITCH) = (w0.z & 0xffffu) | (w1.z << 16); *(LAS unsigned*)(vb + 5 * VPITCH) = (w0.z >> 16) | (w1.z & 0xffff0000u);
            *(LAS unsigned*)(vb + 6 * VPITCH) = (w0.w & 0xffffu) | (w1.w << 16); *(LAS unsigned*)(vb + 7 * VPITCH) = (w0.w >> 16) | (w1.w & 0xffff0000u);
        }
        __syncthreads();
        {
            const int cn = ATT_NEXT(ci);
            if (cn < 5) {
                const int kbn = ATT_KBASE(cn);
#pragma unroll
                for (int i = 0; i < 2; ++i) { const int q = tid + 512 * i, key = q >> 3, slab = q & 7;
                    kw[i] = *(GAS const u32x4*)(P1g + (size_t)(kbn + key) * P1LD + 64 * h + 8 * slab); }
                w0 = *(GAS const u32x4*)(P1g + (size_t)(kbn + 2 * pr) * P1LD + 128 + 64 * h + 8 * vslab);
                w1 = *(GAS const u32x4*)(P1g + (size_t)(kbn + 2 * pr + 1) * P1LD + 128 + 64 * h + 8 * vslab);
            }
            asm volatile("" ::: "memory");
        }
        f32x16 st[4];
        __builtin_amdgcn_s_setprio(1);
#pragma unroll
        for (int kt = 0; kt < 4; ++kt) {
#pragma unroll
            for (int r = 0; r < 16; ++r) st[kt][r] = 0.f;
#pragma unroll
            for (int ks = 0; ks < 4; ++ks) {
                const bf16x8 kf = *(const LAS bf16x8*)(Kl + (32 * kt + l31) * KPITCH + 32 * ks + 16 * hi);
                st[kt] = __builtin_amdgcn_mfma_f32_32x32x16_bf16(kf, qf[ks], st[kt], 0, 0, 0);
            }
        }
        __builtin_amdgcn_s_setprio(0);
        __builtin_amdgcn_sched_barrier(0);
        float mx = -1e30f;
        if (mask) {
            int klo = (mask == 1) ? qq : -1, khi = (mask == 2) ? qq : 1000;
            asm volatile("" : "+v"(klo), "+v"(khi));
#pragma unroll
            for (int kt = 0; kt < 4; ++kt)
#pragma unroll
                for (int r = 0; r < 16; ++r) {
                    const int kk = 32 * kt + 8 * (r >> 2) + 4 * hi + (r & 3);
                    st[kt][r] = (kk >= klo && kk <= khi) ? st[kt][r] : -1e30f;
                }
        }
#pragma unroll
        for (int kt = 0; kt < 4; ++kt)
#pragma unroll
            for (int r = 0; r < 16; ++r) mx = fmaxf(mx, st[kt][r]);
        mx = fmaxf(mx, xor32(mx, hi != 0)) * LOG2E;
        const float mnew = fmaxf(mrun, mx), alpha = __builtin_amdgcn_exp2f(mrun - mnew);
        float rs = 0.f;
        __builtin_amdgcn_sched_barrier(0);
#pragma unroll
        for (int kt = 0; kt < 4; ++kt)
#pragma unroll
            for (int r = 0; r < 16; ++r) { const float e = __builtin_amdgcn_exp2f(fmaf(st[kt][r], LOG2E, -mnew)); st[kt][r] = e; rs += e; }
        rs += xor32(rs, hi != 0);
        lrun = lrun * alpha + rs; mrun = mnew;
#pragma unroll
        for (int dt = 0; dt < 2; ++dt)
#pragma unroll
            for (int r = 0; r < 16; ++r) ot[dt][r] *= alpha;
#pragma unroll
        for (int kt = 0; kt < 4; ++kt)
#pragma unroll
            for (int s = 0; s < 2; ++s) {
                __builtin_amdgcn_sched_barrier(0);
                u32x4 pw; pw.x = pk2(st[kt][8 * s + 0], st[kt][8 * s + 1]); pw.y = pk2(st[kt][8 * s + 2], st[kt][8 * s + 3]);
                pw.z = pk2(st[kt][8 * s + 4], st[kt][8 * s + 5]); pw.w = pk2(st[kt][8 * s + 6], st[kt][8 * s + 7]);
                const bf16x8 pf = __builtin_bit_cast(bf16x8, pw);
#pragma unroll
                for (int dt = 0; dt < 2; ++dt) {
                    const LAS unsigned char* va = Vt + (32 * dt + l31) * VPITCH + (32 * kt + 16 * s + 4 * hi) * 2;
                    const u32x2 a0 = *(const LAS u32x2*)va, a1 = *(const LAS u32x2*)(va + 16);
                    u32x4 aw; aw.x = a0.x; aw.y = a0.y; aw.z = a1.x; aw.w = a1.y;
                    ot[dt] = __builtin_amdgcn_mfma_f32_32x32x16_bf16(__builtin_bit_cast(bf16x8, aw), pf, ot[dt], 0, 0, 0);
                }
            }
    }
    const float sink = p.attn_sink[l * 8 + head] * LOG2E;
    const float inv = 1.f / (lrun + __builtin_amdgcn_exp2f(sink - mrun));
    bf16_t* orow = AM + (size_t)(qrow0 + qq) * 1280 + head * 64;
#pragma unroll
    for (int dt = 0; dt < 2; ++dt)
#pragma unroll
        for (int rq = 0; rq < 4; ++rq) {
            u32x2 o; o.x = pk2(ot[dt][4 * rq] * inv, ot[dt][4 * rq + 1] * inv); o.y = pk2(ot[dt][4 * rq + 2] * inv, ot[dt][4 * rq + 3] * inv);
            *(u32x2*)(orow + 32 * dt + 8 * rq + 4 * hi) = o;
        }
}

__device__ void fft_item(const Params& p, int item, bool isctx, LAS unsigned char* lds) {
    const int tid = otid();
    const int b = item >> 6, quad = item & 63;
    const int logN = isctx ? 8 : 12, N = 1 << logN;
    const int rowbase = isctx ? NL + b * 256 : b * 4096;
    LAS f32x2* data = (LAS f32x2*)lds;
    LAS f32x2* tw = (LAS f32x2*)(lds + 65536);
    __syncthreads();
    {
        GAS const bf16_t* src = (GAS const bf16_t*)(unsigned long long)(p.ws + OFF_P1) + (size_t)rowbase * P1LD + 1024 + quad * 4;
        u32x2 v[8];
#pragma unroll
        for (int q = 0; q < 8; ++q) { const int t = tid + 512 * q; v[q] = (t < N) ? *(GAS const u32x2*)(src + (size_t)t * P1LD) : (u32x2){0u, 0u}; }
        asm volatile("" ::: "memory");
#pragma unroll
        for (int q = 0; q < 8; ++q) { const int t = tid + 512 * q;
            if (t < N) { f32x2 a; a.x = bflo(v[q].x); a.y = bfhi(v[q].x); data[t] = a; f32x2 c; c.x = bflo(v[q].y); c.y = bfhi(v[q].y); data[N + t] = c; } }
    }
    __syncthreads();
    for (int sh = logN - 1; sh >= 1; sh -= 2) {
        const int q = 1 << (sh - 1), ng = 2 << (logN - 2);
        const LAS f32x2* tw1 = tw + (2 * q - 1);
        const LAS f32x2* tw2 = tw + (q - 1);
#pragma unroll 2
        for (int gi = tid; gi < ng; gi += 512) {
            const int f = gi >> (logN - 2), bb = gi & ((N >> 2) - 1);
            const int j = bb & (q - 1), i = ((bb - j) << 2) + j;
            LAS f32x2* X = data + f * N;
            const f32x2 a0 = X[i], a1 = X[i + q], a2 = X[i + 2 * q], a3 = X[i + 3 * q];
            const f32x2 wa = tw1[j], wb = tw1[j + q], wc2 = tw2[j];
            const f32x2 s0 = a0 + a2, d0 = a0 - a2, s1 = a1 + a3, d1 = a1 - a3;
            f32x2 t0, t1; t0.x = d0.x * wa.x + d0.y * wa.y; t0.y = d0.y * wa.x - d0.x * wa.y; t1.x = d1.x * wb.x + d1.y * wb.y; t1.y = d1.y * wb.x - d1.x * wb.y;
            const f32x2 e0 = s0 - s1, e1 = t0 - t1;
            f32x2 r1, r3; r1.x = e0.x * wc2.x + e0.y * wc2.y; r1.y = e0.y * wc2.x - e0.x * wc2.y; r3.x = e1.x * wc2.x + e1.y * wc2.y; r3.y = e1.y * wc2.x - e1.x * wc2.y;
            X[i] = s0 + s1; X[i + q] = r1; X[i + 2 * q] = t0 + t1; X[i + 3 * q] = r3;
        }
        __syncthreads();
    }
    const float hs = isctx ? (0.5f / 128.f) : (0.5f / 512.f);
    bf16_t* AM = (bf16_t*)(p.ws + OFF_AM);
    const int g = quad >> 4, cc0 = 4 * (quad & 15);
#pragma unroll 1
    for (int i1 = tid; i1 < N; i1 += 512) {
        const int k = (int)(__brev((unsigned)i1) >> (32 - logN));
        const int k2 = (N - k) & (N - 1);
        const int i2 = (int)(__brev((unsigned)k2) >> (32 - logN));
        float re[4], im[4];
#pragma unroll
        for (int f = 0; f < 2; ++f) {
            const f32x2 X = data[f * N + i1], Y = data[f * N + i2];
            re[2 * f] = (X.x + Y.x) * hs; im[2 * f] = (X.y - Y.y) * hs; re[2 * f + 1] = (X.y + Y.y) * hs; im[2 * f + 1] = (Y.x - X.x) * hs;
        }
        bf16_t* dst = AM + (size_t)(rowbase + k) * 1280 + 768 + g * 128 + cc0;
        u32x2 o; o.x = pk2(re[0], re[1]); o.y = pk2(re[2], re[3]);
        *(u32x2*)dst = o;
        o.x = pk2(im[0], im[1]); o.y = pk2(im[2], im[3]);
        *(u32x2*)(dst + 64) = o;
    }
}

__device__ void pool_item(const Params& p, int item) {
    const int tid = otid();
    const int row = item * 16 + (tid >> 5), co = tid & 31, w = 2 << (co >> 3);
    int base, T;
    if (row < NL) { base = row & ~4095; T = 4096; } else { base = NL + ((row - NL) & ~255); T = 256; }
    const int tt = row - base;
    int lo = tt - (w >> 1), hi = lo + w; lo = lo < 0 ? 0 : lo; hi = hi > T ? T : hi;
    const bf16_t* U = (const bf16_t*)(p.ws + OFF_P1) + 768 + 8 * co;
    float s[8];
#pragma unroll
    for (int q = 0; q < 8; ++q) s[q] = 0.f;
    const int wlo = tt - (w >> 1);
    {
        GAS const bf16_t* Ug = (GAS const bf16_t*)(unsigned long long)U;
        u32x4 pv[16];
#pragma unroll
        for (int jj = 0; jj < 16; ++jj) { int j = wlo + jj; j = j < 0 ? 0 : (j >= T ? T - 1 : j); pv[jj] = *(GAS const u32x4*)(Ug + (size_t)(base + j) * P1LD); }
        asm volatile("" ::: "memory");
#pragma unroll
        for (int jj = 0; jj < 16; ++jj) {
            const int j = wlo + jj; const float mk = (jj < w && j >= 0 && j < T) ? 1.f : 0.f; const u32x4 v = pv[jj];
            s[0] += mk * bflo(v.x); s[1] += mk * bfhi(v.x); s[2] += mk * bflo(v.y); s[3] += mk * bfhi(v.y); s[4] += mk * bflo(v.z); s[5] += mk * bfhi(v.z); s[6] += mk * bflo(v.w); s[7] += mk * bfhi(v.w);
        }
    }
    const float ic = 1.f / (float)(hi - lo);
    const u32x4 v = *(const u32x4*)(U + (size_t)row * P1LD);
    u32x4 o; o.x = pk2(s[0] * ic - bflo(v.x), s[1] * ic - bfhi(v.x)); o.y = pk2(s[2] * ic - bflo(v.y), s[3] * ic - bfhi(v.y));
    o.z = pk2(s[4] * ic - bflo(v.z), s[5] * ic - bfhi(v.z)); o.w = pk2(s[6] * ic - bflo(v.w), s[7] * ic - bfhi(v.w));
    *(u32x4*)((bf16_t*)(p.ws + OFF_AM) + (size_t)row * 1280 + 512 + 8 * co) = o;
}

__device__ void phase_mix(const Params& p, int l, LAS unsigned char* lds) {
    const int n_attn = (l == 0) ? 544 : 512, n_fft = (l == 0) ? 512 : 256, n_pool = ((l == 0) ? NR : NL) / 16;
    const int total = n_attn + n_fft + n_pool;
    { const int tid = otid(); GAS const f32x2* TW = (GAS const f32x2*)(unsigned long long)(p.ws + OFF_TW); LAS f32x2* tw = (LAS f32x2*)(lds + 65536);
      f32x2 tv[8];
#pragma unroll
      for (int q = 0; q < 8; ++q) { const int i = tid + 512 * q; tv[q] = TW[i < 4095 ? i : 4094]; }
      asm volatile("" ::: "memory");
#pragma unroll
      for (int q = 0; q < 8; ++q) { const int i = tid + 512 * q; if (i < 4095) tw[i] = tv[q]; } }
    for (int rep = 0; rep < ((PROBE & 7) && PROBE < 100 ? 2 : 1); ++rep)
    for (int it = blockIdx.x; it < total; it += gridDim.x) {
        if (it < n_attn) { const int ia = (it < 512) ? ((it & 255) * 2 + (it >> 8)) : it;
            if (rep == 0 || (PROBE & 1)) attn_item(p, l, ia, lds); }
        else if (it < n_attn + n_fft) { const int j = it - n_attn; if (rep == 0 || (PROBE & 2)) { if (j < 256) fft_item(p, j, false, lds); else fft_item(p, j - 256, true, lds); } }
        else { if (rep == 0 || (PROBE & 4)) pool_item(p, it - n_attn - n_fft); }
    }
}

constexpr int N_PHASES = 18;
__global__ void __launch_bounds__(512) mega(Params pk) {
    extern __shared__ __attribute__((aligned(16))) unsigned char shm[];
    LAS unsigned char* lds = (LAS unsigned char*)shm;
    cg::grid_group grid = cg::this_grid();
    LAS Params* lp = (LAS Params*)(lds + PRM_OFF);
    if (threadIdx.x < 23) ((LAS unsigned long long*)lp)[threadIdx.x] = ((const unsigned long long*)&pk)[threadIdx.x];
    if (threadIdx.x < 4) ((LAS unsigned*)(lds + PRM_OFF + 512))[threadIdx.x] = 0u;
    __syncthreads();
    const XcdBarrier xb = xcd_barrier_post((unsigned*)(pk.ws + OFF_BAR), (volatile LAS unsigned*)(lds + PRM_OFF + 512));
    const int ph_lo = __builtin_amdgcn_readfirstlane(lp->ph_lo), ph_hi = __builtin_amdgcn_readfirstlane(lp->ph_hi);
    for (int ph = ph_lo; ph < ph_hi; ++ph) {
        const int l = (ph - 1) / 8, sub = (ph == 0) ? 9 : (((ph - 1) % 8) == 7 ? 8 : (ph - 1) % 8);
        int nrep = 1;
#if PROBE >= 100
        if (ph < N_PHASES - 1 && sub == (PROBE % 100)) nrep = 2;
#endif
        for (int rep = 0; rep < nrep; ++rep) {
            const bool dry = (PROBE >= 200) && (rep == 0) && (nrep == 2);
            if (ph == 0) { const Params p = load_params(lp); phase_prep(p, lds); }
            else if (ph == N_PHASES - 1) { const Params p = load_params(lp); phase_final(p); }
            else if (sub == 0 || sub == 5) { const Params p = load_params(lp); phase_norm(p, l, sub == 5); }
            else if (sub == 2) { const Params p = load_params(lp); phase_mix(p, l, lds); }
            else { for (int gi = 0; gi < 6; ++gi) { if (!gemm_phase(lds, l, sub, gi, dry)) break; } }
            if (rep + 1 < nrep) xcd_barrier(xb);
        }
        if (ph + 1 < ph_hi) xcd_barrier(xb);
        if (ph_hi > 1000) grid.sync();
    }
}

extern "C" void kernel_launch(void* const* d_in, const int* in_sizes, int n_in, void* d_out, int out_size, void* d_ws, size_t ws_size, hipStream_t stream) {
    static int grid_blocks = 0;
    if (!grid_blocks) {
        int dev = 0, cus = 0, per_cu = 0;
        hipGetDevice(&dev);
        hipDeviceGetAttribute(&cus, hipDeviceAttributeMultiprocessorCount, dev);
        hipFuncSetAttribute((const void*)mega, hipFuncAttributeMaxDynamicSharedMemorySize, LDS_BYTES);
        if (hipOccupancyMaxActiveBlocksPerMultiprocessor(&per_cu, (const void*)mega, 512, LDS_BYTES) != hipSuccess || per_cu < 1) per_cu = 1;
        (void)hipGetLastError();
        if (per_cu > 1) per_cu = 1;
        grid_blocks = cus * per_cu;
        if (ws_size < 256 * MiB) fprintf(stderr, "kernel_launch: workspace too small (%zu)\n", ws_size);
    }
    Params p{};
    const float** pp = (const float**)&p;
    for (int i = 0; i < 20; ++i) pp[i] = (const float*)d_in[i];
    p.out = (float*)d_out; p.ws = (unsigned char*)d_ws; p.ph_lo = 0; p.ph_hi = N_PHASES;
    (void)hipMemsetAsync((char*)d_ws + OFF_BAR, 0, XCD_BAR_WORDS * 4, stream);
    void* args[] = {&p};
    hipError_t e = hipLaunchCooperativeKernel((const void*)mega, dim3(grid_blocks), dim3(512), args, LDS_BYTES, stream);
    if (e != hipSuccess) fprintf(stderr, "cooperative launch failed: %s (grid %d)\n", hipGetErrorString(e), grid_blocks);
}
```

```cpp
#include <hip/hip_runtime.h>
#include <hip/hip_cooperative_groups.h>
#include <cstdio>
namespace cg = cooperative_groups;
#ifndef PROBE
#define PROBE 0
#endif

#define LAS __attribute__((address_space(3)))
typedef unsigned short bf16_t;
typedef short bf16x8 __attribute__((ext_vector_type(8)));
typedef float f32x2 __attribute__((ext_vector_type(2)));
typedef float f32x4 __attribute__((ext_vector_type(4)));
typedef float f32x16 __attribute__((ext_vector_type(16)));
typedef unsigned u32x2 __attribute__((ext_vector_type(2)));
typedef unsigned u32x4 __attribute__((ext_vector_type(4)));

constexpr int NL = 16384, NCX = 1024, NR = NL + NCX, DM = 1024;
constexpr int INW = 4352, DFF = 2816, DFH = 1408;
constexpr int P1LD = 1280;
constexpr int LDS_BYTES = 147456 + 1024, PRM_OFF = 147456;
constexpr float LOG2E = 1.4426950408889634f;

constexpr size_t MiB = 1048576;
constexpr size_t OFF_MOD = 0;
constexpr size_t OFF_ROPE = 262144;
constexpr size_t OFF_TW = 262144 + 16384;
constexpr size_t OFF_BAR = 1 * MiB;
constexpr size_t OFF_XC = 2 * MiB;
constexpr size_t OFF_W = 6 * MiB;
constexpr size_t LW_WIN = 0, LW_WM = (size_t)INW * 1024 * 2, LW_WO = LW_WM + (size_t)1024 * 1280 * 2, LW_WUP = LW_WO + (size_t)1024 * 1024 * 2,
                 LW_WD = LW_WUP + (size_t)5632 * 1024 * 2, LW = LW_WD + (size_t)1024 * DFF * 2;
constexpr size_t OFF_H = 65 * MiB;
constexpr size_t OFF_R = 99 * MiB;
constexpr size_t OFF_P1 = OFF_R;
constexpr size_t OFF_AM = OFF_R + 85 * MiB / 2;
constexpr size_t OFF_YM = OFF_AM + 85 * MiB / 2;
constexpr size_t OFF_ACT = OFF_R;
constexpr size_t OFF_HB = OFF_R + 94 * MiB;
constexpr size_t OFF_PART = 198 * MiB;
constexpr size_t OFF_GC = 218 * MiB;
static_assert(OFF_W + 2 * LW == OFF_H, "weights region");
static_assert(OFF_YM + 34 * MiB <= 256 * MiB && OFF_ACT + (size_t)NR * DFF * 2 <= OFF_HB && OFF_HB + 4 * MiB <= 256 * MiB, "ws");

struct Params {
    const float *x, *c, *ctx, *c_ctx, *w_mod, *b_mod, *norm_mix, *norm_ffn, *w_in, *attn_sink, *pool_w, *pool_scale,
        *w_br_attn, *w_br_pool, *w_br_four, *w_out, *w_up, *conv_w, *w_down, *norm_final;
    float* out; unsigned char* ws; int ph_lo, ph_hi;
};

__device__ __forceinline__ unsigned pk2(float lo, float hi) { unsigned r; asm volatile("v_cvt_pk_bf16_f32 %0, %1, %2" : "=v"(r) : "v"(lo), "v"(hi)); return r; }
__device__ __forceinline__ float bflo(unsigned w) { return __uint_as_float(w << 16); }
__device__ __forceinline__ float bfhi(unsigned w) { return __uint_as_float(w & 0xffff0000u); }
__device__ __forceinline__ float wave_sum(float v) {
#pragma unroll
    for (int o = 1; o < 64; o <<= 1) v += __shfl_xor(v, o);
    return v;
}
__device__ __forceinline__ Params load_params(LAS const Params* lp) { Params p;
#pragma unroll
    for (int i = 0; i < 23; ++i) ((unsigned long long*)&p)[i] = ((LAS const unsigned long long*)lp)[i];
    return p; }
__device__ __forceinline__ int otid() { int t = threadIdx.x; asm volatile("" : "+v"(t)); return t; }
template <class T> __device__ __forceinline__ T* uptr(T* q) { const unsigned long long v = (unsigned long long)q; const unsigned lo = __builtin_amdgcn_readfirstlane((unsigned)v), hi = __builtin_amdgcn_readfirstlane((unsigned)(v >> 32)); return (T*)(((unsigned long long)hi << 32) | lo); }
__device__ __forceinline__ float fast_sigmoid(float x) { return __builtin_amdgcn_rcpf(1.0f + __builtin_amdgcn_exp2f(-x * LOG2E)); }


#define XB_TMO      128
#define XB_XCNT(j)  (256  + 64 * (j))
#define XB_XSUB(j)  (1280 + 64 * (j))
#define XB_XGEN(j)  (2304 + 64 * (j))
#define XB_TOP      3328
#define XB_TOPGEN   3392
#define XCD_BAR_WORDS 3456
#define XB_SPIN_CAP (1u << 18)
__device__ __forceinline__ unsigned xb_ld(unsigned* p)              { return __hip_atomic_load(p, __ATOMIC_RELAXED, __HIP_MEMORY_SCOPE_AGENT); }
__device__ __forceinline__ unsigned xb_add(unsigned* p, unsigned v) { return __hip_atomic_fetch_add(p, v, __ATOMIC_RELAXED, __HIP_MEMORY_SCOPE_AGENT); }
__device__ __forceinline__ unsigned xb_xcc_id() { return (unsigned)__builtin_amdgcn_s_getreg((3 << 11) | 20) & 0xFu; }
#define XB_SPIN(cond, bar) do { unsigned _sp = 0; while (cond) { __builtin_amdgcn_s_sleep(1); \
    if ((++_sp & 255u) == 0u) { if (xb_ld(&(bar)[XB_TMO])) break; if (_sp > XB_SPIN_CAP) { atomicAdd(&(bar)[XB_TMO], 1u); break; } } } } while (0)
struct XcdBarrier { unsigned* bar; unsigned x; volatile LAS unsigned* st; };
__device__ __forceinline__ XcdBarrier xcd_barrier_post(unsigned* bar, volatile LAS unsigned* st) {
    XcdBarrier b; b.bar = bar; b.x = xb_xcc_id(); b.st = st;
    if (threadIdx.x == 0) (void)xb_add(&bar[XB_XCNT(b.x)], 1u);
    return b;
}
__device__ __forceinline__ void xcd_barrier_complete(unsigned* bar, unsigned x, unsigned& nloc, unsigned& nx) {
    const unsigned G = gridDim.x * gridDim.y * gridDim.z;
    unsigned sum, cnt, mine, sp = 0u;
    for (;;) {
        sum = 0u; cnt = 0u; mine = 0u;
#pragma unroll
        for (unsigned j = 0; j < 16; ++j) { const unsigned c = xb_ld(&bar[XB_XCNT(j)]); sum += c; cnt += (c > 0u) ? 1u : 0u; mine = (j == x) ? c : mine; }
        if (sum == G) break;
        __builtin_amdgcn_s_sleep(1);
        if ((++sp & 255u) == 0u) { if (xb_ld(&bar[XB_TMO])) break; if (sp > XB_SPIN_CAP) { atomicAdd(&bar[XB_TMO], 1u); break; } }
    }
    nloc = mine > 0u ? mine : 1u; nx = cnt > 0u ? cnt : 1u;
}
__device__ __forceinline__ void xcd_barrier(const XcdBarrier& b) {
    asm volatile("s_waitcnt vmcnt(0)" ::: "memory");
    __syncthreads();
    if (threadIdx.x == 0) {
        unsigned* bar = b.bar;
        __builtin_amdgcn_s_waitcnt(0);
        unsigned nloc = b.st[0], nx = b.st[1];
        if (nloc == 0u) { xcd_barrier_complete(bar, b.x, nloc, nx); b.st[0] = nloc; b.st[1] = nx; }
        const unsigned old = xb_add(&bar[XB_XSUB(b.x)], 1u);
        const unsigned gen = old / nloc;
        if (old + 1u == (gen + 1u) * nloc) {
            __builtin_amdgcn_fence(__ATOMIC_RELEASE, "agent");
            asm volatile("s_waitcnt vmcnt(0)" ::: "memory");
            const unsigned og = xb_add(&bar[XB_TOP], 1u);
            const unsigned tg = og / nx;
            if (og + 1u == (tg + 1u) * nx) xb_add(&bar[XB_TOPGEN], 1u);
            else XB_SPIN(xb_ld(&bar[XB_TOPGEN]) == tg, bar);
            __builtin_amdgcn_fence(__ATOMIC_ACQUIRE, "agent");
            xb_add(&bar[XB_XGEN(b.x)], 1u);
            asm volatile("s_waitcnt vmcnt(0)" ::: "memory");
        } else {
            XB_SPIN(xb_ld(&bar[XB_XGEN(b.x)]) == gen, bar);
            __builtin_amdgcn_fence(__ATOMIC_ACQUIRE, "agent");
            asm volatile("s_waitcnt vmcnt(0)" ::: "memory");
        }
    }
    __syncthreads();
}

constexpr int BM = 256, BK = 64, HALF = 128, HTB = HALF * BK * 2, NXCD = 8, WGM = 4;
__device__ __forceinline__ int lds_byte(int r, int c) { const int st = (r >> 4) * 2 + (c >> 5), rr = r & 15, cc = c & 31, ob = rr * 64 + cc * 2; return st * 1024 + (ob ^ (((ob >> 9) & 1) << 5)); }
__device__ __forceinline__ void stage_rc(int b, int& R, int& C) { const int st = b / 1024, sb = b % 1024, swz = sb ^ (((sb >> 9) & 1) << 5); R = (st >> 1) * 16 + swz / 64; C = (st & 1) * 32 + (swz % 64) / 2; }
__device__ __forceinline__ int perm32(int rho) { const int n = rho >> 4, i = rho & 15; return 8 * (i >> 2) + 4 * n + (i & 3); }

enum { M_P1 = 0, M_BF16 = 1, M_GATE = 2, M_YSET = 3, M_YADD = 4, M_RES = 5, M_UPC = 6 };
struct GD {
    const bf16_t* A; const bf16_t* Bt; int lda, ldb, K, nM, nN, row0, mode, splitk;
    bf16_t* out; int ldc; const bf16_t* aux;
    const float* gm; const float* xin_lat; const float* xin_ctx; float* xout_lat; float* xout_ctx;
    const float* rope; const float* cw;
    int sctx, xctx; bf16_t* auxc;
};
struct Unit { int pm, pn, k0; };
constexpr int SK_S = 11, SK_NT = 4;
__device__ __forceinline__ bool unit_next(const GD& g, int i, Unit& u) {
    int nM = g.nM; const int nN = g.nN;
    const long L = (long)i * gridDim.x + blockIdx.x;
    u.k0 = 0;
    if (g.splitk) {
        if (L >= 16 * SK_S) return false;
        const int tile = (int)(L / SK_S), ks = (int)(L % SK_S); u.pm = 64 + (tile >> 2); u.pn = tile & 3; u.k0 = ks * SK_NT; return true;
    }
    if (g.sctx) {
        nM = 64;
        const long nb = (long)nM * nN;
        if (L >= nb) { const int sidx = (int)(L - nb), wN = nN + g.xctx; if (sidx >= 4 * wN) return false; u.pm = 64 + sidx / wN; u.pn = sidx % wN; return true; }
    }
    const int nwg = nM * nN;
    if (L >= nwg) return false;
    int wgid = (int)L; { const int q = nwg / NXCD, r = nwg % NXCD, xcd = wgid % NXCD, off = wgid / NXCD; wgid = (xcd < r ? xcd * (q + 1) : r * (q + 1) + (xcd - r) * q) + off; }
    const int wgm = (nN > 8) ? 8 : WGM;
    const int nig = wgm * nN, gid = wgid / nig, fm = gid * wgm, gsz = (nM - fm) < wgm ? (nM - fm) : wgm;
    u.pm = fm + ((wgid % nig) % gsz); u.pn = (wgid % nig) / gsz; return true;
}

#ifndef MB
#define MB 1
#endif
#ifndef MBR
#define MBR 4
#endif
#ifndef MBG
#define MBG 4
#endif
#define GAS __attribute__((address_space(1)))
__device__ __forceinline__ unsigned char* lds_params_ws(LAS unsigned char* lds) { return ((LAS const Params*)(lds + PRM_OFF))->ws; }
template <class T> __device__ __forceinline__ GAS T* gptr(T* q) { return (GAS T*)(unsigned long long)uptr(q); }
__device__ __forceinline__ void gemm_epilogue(LAS unsigned char* lds, const GD& gd, const f32x4 (&acc)[2][2][4][2], const Unit& u) {
    const int tid_e = otid(), wid_e = __builtin_amdgcn_readfirstlane(tid_e >> 6), wr = wid_e >> 2, wc = wid_e & 3, fr = tid_e & 15, fq = (tid_e >> 4) & 3;
    const int mode = __builtin_amdgcn_readfirstlane(gd.mode);
    const int row_u = __builtin_amdgcn_readfirstlane(gd.row0) + u.pm * BM;
    const int lrow = wr * 64 + fr;
    if (mode == M_UPC) {
        const int chl = wc * 32 + 8 * fq;
        GAS const float* cwu = gptr(gd.cw + u.pn * 128);
        f32x4 cwv[2][3], cwg[2][3];
#pragma unroll
        for (int n = 0; n < 2; ++n)
#pragma unroll
            for (int tp = 0; tp < 3; ++tp) { cwv[n][tp] = *(GAS const f32x4*)(cwu + tp * 5632 + chl + 4 * n); cwg[n][tp] = *(GAS const f32x4*)(cwu + tp * 5632 + DFF + chl + 4 * n); }
        asm volatile("" ::: "memory");
        LAS float* EX = (LAS float*)(lds + 131072);
#define EXI(ai_, wr_, tb_) ((((((ai_) * 2 + (wr_)) * 4 + wc) * 2 + (tb_)) * 4 + fq) * 16)
#pragma unroll
        for (int ai = 0; ai < 2; ++ai)
#pragma unroll
            for (int bj = 0; bj < 2; ++bj)
#pragma unroll
                for (int n = 0; n < 2; ++n) {
                    if (fr == 0) *(LAS f32x4*)(EX + EXI(ai, wr, 0) + bj * 8 + n * 4) = acc[ai][bj][0][n];
                    if (fr == 15) *(LAS f32x4*)(EX + EXI(ai, wr, 1) + bj * 8 + n * 4) = acc[ai][bj][3][n];
                }
        {
            GAS bf16_t* HB = gptr((bf16_t*)gd.aux + (size_t)u.pm * 4 * 5632 + u.pn * 256) + wc * 32 + 8 * fq;
            if (wr == 0 && fr == 0) {
#pragma unroll
                for (int mm = 0; mm < 2; ++mm)
#pragma unroll
                    for (int bj = 0; bj < 2; ++bj) { const f32x4 v0 = acc[0][bj][mm][0], v1 = acc[0][bj][mm][1];
                        u32x4 w; w.x = pk2(v0[0], v0[1]); w.y = pk2(v0[2], v0[3]); w.z = pk2(v1[0], v1[1]); w.w = pk2(v1[2], v1[3]);
                        *(GAS u32x4*)(HB + mm * 5632 + bj * HALF) = w; }
            }
            if (wr == 1 && fr == 15) {
#pragma unroll
                for (int mm = 2; mm < 4; ++mm)
#pragma unroll
                    for (int bj = 0; bj < 2; ++bj) { const f32x4 v0 = acc[1][bj][mm][0], v1 = acc[1][bj][mm][1];
                        u32x4 w; w.x = pk2(v0[0], v0[1]); w.y = pk2(v0[2], v0[3]); w.z = pk2(v1[0], v1[1]); w.w = pk2(v1[2], v1[3]);
                        *(GAS u32x4*)(HB + mm * 5632 + bj * HALF) = w; }
            }
        }
        asm volatile("s_waitcnt lgkmcnt(0)" ::: "memory");
        __builtin_amdgcn_s_barrier();
        __builtin_amdgcn_s_barrier();
        asm volatile("" ::: "memory");
        GAS bf16_t* outu = gptr(gd.out + (size_t)row_u * DFF + u.pn * 128);
        const unsigned ooff = (unsigned)((wr * 64 + 4 * fr) * DFF + chl);
#pragma unroll
        for (int ai = 0; ai < 2; ++ai) {
            const bool has_prev = !(ai == 0 && wr == 0), has_next = !(ai == 1 && wr == 1);
            const int pa = wr ? ai : ai - 1, pw = wr ? 0 : 1, na = wr ? ai + 1 : ai, nw = wr ? 0 : 1;
            unsigned actw[4][4];
#pragma unroll
            for (int n = 0; n < 2; ++n) {
                f32x4 ep[2], en[2];
#pragma unroll
                for (int bj = 0; bj < 2; ++bj) {
                    ep[bj] = has_prev ? *(const LAS f32x4*)(EX + EXI(pa, pw, 1) + bj * 8 + n * 4) : (f32x4){0.f, 0.f, 0.f, 0.f};
                    en[bj] = has_next ? *(const LAS f32x4*)(EX + EXI(na, nw, 0) + bj * 8 + n * 4) : (f32x4){0.f, 0.f, 0.f, 0.f};
                }
#pragma unroll
                for (int jp = 0; jp < 2; ++jp) {
                    f32x2 cv[2][4];
#pragma unroll
                    for (int bj = 0; bj < 2; ++bj) {
                        const f32x4 W0 = bj ? cwg[n][0] : cwv[n][0], W1 = bj ? cwg[n][1] : cwv[n][1], W2 = bj ? cwg[n][2] : cwv[n][2];
                        f32x2 w0, w1, w2;
                        w0.x = W0[2 * jp]; w0.y = W0[2 * jp + 1]; w1.x = W1[2 * jp]; w1.y = W1[2 * jp + 1]; w2.x = W2[2 * jp]; w2.y = W2[2 * jp + 1];
                        f32x2 cur[4];
#pragma unroll
                        for (int m = 0; m < 4; ++m) { cur[m].x = acc[ai][bj][m][n][2 * jp]; cur[m].y = acc[ai][bj][m][n][2 * jp + 1]; }
                        float pvx = __builtin_bit_cast(float, __builtin_amdgcn_update_dpp(0, __builtin_bit_cast(int, (float)cur[3].x), 0x121, 0xF, 0xF, false));
                        float pvy = __builtin_bit_cast(float, __builtin_amdgcn_update_dpp(0, __builtin_bit_cast(int, (float)cur[3].y), 0x121, 0xF, 0xF, false));
                        float nxx = __builtin_bit_cast(float, __builtin_amdgcn_update_dpp(0, __builtin_bit_cast(int, (float)cur[0].x), 0x12F, 0xF, 0xF, false));
                        float nxy = __builtin_bit_cast(float, __builtin_amdgcn_update_dpp(0, __builtin_bit_cast(int, (float)cur[0].y), 0x12F, 0xF, 0xF, false));
                        pvx = (fr == 0) ? ep[bj][2 * jp] : pvx; pvy = (fr == 0) ? ep[bj][2 * jp + 1] : pvy;
                        nxx = (fr == 15) ? en[bj][2 * jp] : nxx; nxy = (fr == 15) ? en[bj][2 * jp + 1] : nxy;
                        f32x2 above, below; above.x = pvx; above.y = pvy; below.x = nxx; below.y = nxy;
#pragma unroll
                        for (int m = 0; m < 4; ++m) {
                            const f32x2 pv = (m == 0) ? above : cur[m > 0 ? m - 1 : 0];
                            const f32x2 nx = (m == 3) ? below : cur[m < 3 ? m + 1 : 3];
                            cv[bj][m] = w0 * pv + w1 * cur[m] + w2 * nx;
                        }
                    }
#pragma unroll
                    for (int m = 0; m < 4; ++m) {
                        const f32x2 gq = cv[1][m];
                        f32x2 sg; sg.x = fast_sigmoid(gq.x); sg.y = fast_sigmoid(gq.y);
                        const f32x2 a2 = cv[0][m] * gq * sg;
                        actw[m][2 * n + jp] = pk2(a2.x, a2.y);
                    }
                }
            }
#pragma unroll
            for (int m = 0; m < 4; ++m) {
                u32x4 o; o.x = actw[m][0]; o.y = actw[m][1]; o.z = actw[m][2]; o.w = actw[m][3];
                *(GAS u32x4*)(outu + ooff + (ai * HALF + m) * DFF) = o;
            }
        }
#undef EXI
        return;
    }
    if (mode == M_RES) {
        const bool lat = row_u < NL;
        const int rb = lat ? (row_u >> 12) : 4;
        GAS const float* gmr = gptr(gd.gm + rb * 6144 + u.pn * BM);
        GAS const float* xin = gptr((lat ? gd.xin_lat : gd.xin_ctx - (size_t)NL * DM) + (size_t)row_u * DM + u.pn * BM);
        GAS float* xout = gptr((lat ? gd.xout_lat : gd.xout_ctx - (size_t)NL * DM) + (size_t)row_u * DM + u.pn * BM);
        const int lcol = wc * 32 + 4 * fq;
        const unsigned xoff = (unsigned)(lrow * DM + lcol);
        f32x4 gv[2][2];
#pragma unroll
        for (int bj = 0; bj < 2; ++bj)
#pragma unroll
            for (int n = 0; n < 2; ++n) gv[bj][n] = *(GAS const f32x4*)(gmr + lcol + bj * HALF + n * 16);
        if (gd.splitk) {
            GAS float* part = gptr((float*)(lds_params_ws(lds) + OFF_PART) + ((size_t)(u.k0 / SK_NT) * 1024 + (row_u - NL)) * DM + u.pn * BM);
#pragma unroll
            for (int ai = 0; ai < 2; ++ai)
#pragma unroll
                for (int m = 0; m < 4; ++m)
#pragma unroll
                    for (int bj = 0; bj < 2; ++bj)
#pragma unroll
                        for (int n = 0; n < 2; ++n) *(GAS f32x4*)(part + xoff + (ai * HALF + m * 16) * DM + bj * HALF + n * 16) = gv[bj][n] * acc[ai][bj][m][n];
            return;
        }
#pragma unroll
        for (int am = 0; am < 8 / MBR; ++am) {
            const int ai = (am * MBR) >> 2, m0 = (am * MBR) & 3;
            f32x4 xi[MBR][2][2];
#pragma unroll
            for (int mm = 0; mm < MBR; ++mm)
#pragma unroll
                for (int bj = 0; bj < 2; ++bj)
#pragma unroll
                    for (int n = 0; n < 2; ++n) xi[mm][bj][n] = *(GAS const f32x4*)(xin + xoff + (ai * HALF + (m0 + mm) * 16) * DM + bj * HALF + n * 16);
            asm volatile("" ::: "memory");
#pragma unroll
            for (int mm = 0; mm < MBR; ++mm)
#pragma unroll
                for (int bj = 0; bj < 2; ++bj)
#pragma unroll
                    for (int n = 0; n < 2; ++n) *(GAS f32x4*)(xout + xoff + (ai * HALF + (m0 + mm) * 16) * DM + bj * HALF + n * 16) = xi[mm][bj][n] + gv[bj][n] * acc[ai][bj][m0 + mm][n];
        }
        return;
    }
    int ldc = __builtin_amdgcn_readfirstlane(gd.ldc);
    const int lcol = wc * 32 + 8 * fq;
    const bool ctx_gate_out = (mode == M_P1) && (u.pn >= 5);
    const bool ctx_gate_in = (row_u >= NL) && (gd.auxc != nullptr);
    const int emode = ctx_gate_out ? (int)M_GATE : mode;
    if (ctx_gate_out) ldc = 3072;
    const int apitch = ctx_gate_in ? 3072 : 1024;
    GAS bf16_t* outu = gptr(ctx_gate_out ? gd.auxc + (size_t)(row_u - NL) * 3072 + (u.pn - 5) * BM : gd.out + (size_t)row_u * ldc + u.pn * BM);
    GAS const bf16_t* auxu = gptr(ctx_gate_in ? (const bf16_t*)gd.auxc + (size_t)(row_u - NL) * 3072 + u.pn * BM : gd.aux + (size_t)row_u * 1024 + u.pn * BM);
    const unsigned ooff = (unsigned)(lrow * ldc + lcol), goff = (unsigned)(lrow * apitch + lcol);
    if (mode == M_YSET || mode == M_YADD) {
#pragma unroll
        for (int am = 0; am < 8 / MBG; ++am) {
            const int ai = (am * MBG) >> 2, m0 = (am * MBG) & 3;
            u32x4 gw[MBG][2], yw[MBG][2];
#pragma unroll
            for (int mm = 0; mm < MBG; ++mm)
#pragma unroll
                for (int bj = 0; bj < 2; ++bj) {
                    const int ro = ai * HALF + (m0 + mm) * 16;
                    gw[mm][bj] = *(GAS const u32x4*)(auxu + goff + ro * apitch + bj * HALF);
                    if (mode == M_YADD) yw[mm][bj] = *(GAS const u32x4*)(outu + ooff + ro * ldc + bj * HALF);
                }
            asm volatile("" ::: "memory");
#pragma unroll
            for (int mm = 0; mm < MBG; ++mm) {
                const int m = m0 + mm;
#pragma unroll
                for (int bj = 0; bj < 2; ++bj) {
                    f32x4 v0 = acc[ai][bj][m][0], v1 = acc[ai][bj][m][1];
                    const u32x4 q = gw[mm][bj];
                    v0[0] *= bflo(q.x); v0[1] *= bfhi(q.x); v0[2] *= bflo(q.y); v0[3] *= bfhi(q.y);
                    v1[0] *= bflo(q.z); v1[1] *= bfhi(q.z); v1[2] *= bflo(q.w); v1[3] *= bfhi(q.w);
                    if (mode == M_YADD) {
                        const u32x4 y = yw[mm][bj];
                        v0[0] += bflo(y.x); v0[1] += bfhi(y.x); v0[2] += bflo(y.y); v0[3] += bfhi(y.y);
                        v1[0] += bflo(y.z); v1[1] += bfhi(y.z); v1[2] += bflo(y.w); v1[3] += bfhi(y.w);
                    }
                    u32x4 w; w.x = pk2(v0[0], v0[1]); w.y = pk2(v0[2], v0[3]); w.z = pk2(v1[0], v1[1]); w.w = pk2(v1[2], v1[3]);
                    *(GAS u32x4*)(outu + ooff + (ai * HALF + m * 16) * ldc + bj * HALF) = w;
                }
            }
        }
        return;
    }
    const bool rope_unit = (mode == M_P1) && (row_u < NL) && (u.pn <= 2);
#pragma unroll
    for (int am = 0; am < 8; ++am) {
        const int ai = am >> 2, m = am & 3;
        f32x4 cs[4];
        if (rope_unit) {
            const int row = row_u + lrow + ai * HALF + m * 16;
            const int t = row & 4095, pos = (wc & 1) ? (t & 63) : (t >> 6);
            const LAS f32x4* cp = (const LAS f32x4*)(lds + 139264 + (pos * 16 + 8 * (fq & 1)) * 8);
#pragma unroll
            for (int q = 0; q < 4; ++q) cs[q] = cp[q];
        }
#pragma unroll
        for (int bj = 0; bj < 2; ++bj) {
            f32x4 v0 = acc[ai][bj][m][0], v1 = acc[ai][bj][m][1];
            if (rope_unit && !(u.pn == 0 && bj == 1)) {
                const float sg = (fq < 2) ? -1.f : 1.f;
#pragma unroll
                for (int j = 0; j < 4; ++j) {
                    const float p0 = __shfl_xor(v0[j], 32), p1 = __shfl_xor(v1[j], 32);
                    const float c0 = cs[j >> 1][(j & 1) * 2], s0 = cs[j >> 1][(j & 1) * 2 + 1];
                    const float c1 = cs[2 + (j >> 1)][(j & 1) * 2], s1 = cs[2 + (j >> 1)][(j & 1) * 2 + 1];
                    v0[j] = v0[j] * c0 + sg * p0 * s0; v1[j] = v1[j] * c1 + sg * p1 * s1;
                }
            }
            if (emode == M_GATE) {
#pragma unroll
                for (int j = 0; j < 4; ++j) { v0[j] = fast_sigmoid(v0[j]); v1[j] = fast_sigmoid(v1[j]); }
            }
            u32x4 w; w.x = pk2(v0[0], v0[1]); w.y = pk2(v0[2], v0[3]); w.z = pk2(v1[0], v1[1]); w.w = pk2(v1[2], v1[3]);
            *(GAS u32x4*)(outu + ooff + (ai * HALF + m * 16) * ldc + bj * HALF) = w;
        }
    }
}

__device__ __forceinline__ void fixup_tile(const bf16_t* HBp, bf16_t* ACTp, const float* cwp, int pm) {
    const int tid = otid();
    if (pm >= 64 || tid >= 352) return;
    GAS const bf16_t* HB = (GAS const bf16_t*)(unsigned long long)HBp;
    GAS bf16_t* ACT = (GAS bf16_t*)(unsigned long long)ACTp;
    GAS const float* cw = (GAS const float*)(unsigned long long)cwp;
    const int ch = tid * 8, col = 256 * (ch >> 7) + (ch & 127);
    const bool up_nb = (pm & 15) != 0, dn_nb = (pm & 15) != 15;
    const u32x4 z = {0u, 0u, 0u, 0u};
    GAS const bf16_t* h0 = HB + (size_t)pm * 4 * 5632 + col;
    u32x4 rv[6], rg[6];
    rv[0] = up_nb ? *(GAS const u32x4*)(h0 - 5632) : z;          rg[0] = up_nb ? *(GAS const u32x4*)(h0 - 5632 + 128) : z;
    rv[1] = *(GAS const u32x4*)(h0);                              rg[1] = *(GAS const u32x4*)(h0 + 128);
    rv[2] = *(GAS const u32x4*)(h0 + 5632);                       rg[2] = *(GAS const u32x4*)(h0 + 5632 + 128);
    rv[3] = *(GAS const u32x4*)(h0 + 2 * 5632);                   rg[3] = *(GAS const u32x4*)(h0 + 2 * 5632 + 128);
    rv[4] = *(GAS const u32x4*)(h0 + 3 * 5632);                   rg[4] = *(GAS const u32x4*)(h0 + 3 * 5632 + 128);
    rv[5] = dn_nb ? *(GAS const u32x4*)(h0 + 4 * 5632) : z;      rg[5] = dn_nb ? *(GAS const u32x4*)(h0 + 4 * 5632 + 128) : z;
    float wv[3][8], wg[3][8];
#pragma unroll
    for (int t = 0; t < 3; ++t) {
        const f32x4 a0 = *(GAS const f32x4*)(cw + t * 5632 + ch), a1 = *(GAS const f32x4*)(cw + t * 5632 + ch + 4);
        const f32x4 b0 = *(GAS const f32x4*)(cw + t * 5632 + DFF + ch), b1 = *(GAS const f32x4*)(cw + t * 5632 + DFF + ch + 4);
#pragma unroll
        for (int q = 0; q < 4; ++q) { wv[t][q] = a0[q]; wv[t][4 + q] = a1[q]; wg[t][q] = b0[q]; wg[t][4 + q] = b1[q]; }
    }
    asm volatile("" ::: "memory");
#pragma unroll
    for (int r = 0; r < 2; ++r) {
        if (r == 0 ? !up_nb : !dn_nb) continue;
        float a[8];
#pragma unroll
        for (int q = 0; q < 8; ++q) {
            const int w = q >> 1;
            float v[3], gq[3];
#pragma unroll
            for (int t = 0; t < 3; ++t) {
                const unsigned uv = rv[3 * r + t][w], ug = rg[3 * r + t][w];
                v[t] = (q & 1) ? bfhi(uv) : bflo(uv); gq[t] = (q & 1) ? bfhi(ug) : bflo(ug);
            }
            const float cvv = wv[0][q] * v[0] + wv[1][q] * v[1] + wv[2][q] * v[2];
            const float cg = wg[0][q] * gq[0] + wg[1][q] * gq[1] + wg[2][q] * gq[2];
            a[q] = cvv * cg * fast_sigmoid(cg);
        }
        u32x4 o; o.x = pk2(a[0], a[1]); o.y = pk2(a[2], a[3]); o.z = pk2(a[4], a[5]); o.w = pk2(a[6], a[7]);
        *(GAS u32x4*)(ACT + (size_t)(256 * pm + (r ? 255 : 0)) * DFF + ch) = o;
    }
}

__device__ __forceinline__ bool make_gd(LAS const Params* lp, int l, int sub, int gi, GD& g) {
    Params p; p.ws = lp->ws; p.out = lp->out; p.x = lp->x; p.ctx = lp->ctx;
    unsigned char* ws = p.ws;
    const unsigned char* wb = ws + OFF_W + (size_t)l * LW;
    const bf16_t* WinT = (const bf16_t*)(wb + LW_WIN); const bf16_t* WmT = (const bf16_t*)(wb + LW_WM); const bf16_t* WoT = (const bf16_t*)(wb + LW_WO);
    const bf16_t* WupT = (const bf16_t*)(wb + LW_WUP); const bf16_t* WdT = (const bf16_t*)(wb + LW_WD);
    const bf16_t* H = (const bf16_t*)(ws + OFF_H);
    bf16_t* P1 = (bf16_t*)(ws + OFF_P1); bf16_t* AM = (bf16_t*)(ws + OFF_AM); bf16_t* YM = (bf16_t*)(ws + OFF_YM);
    const float* mod = (const float*)(ws + OFF_MOD) + (size_t)l * 5 * 6144;
    const int mt = (l == 0) ? 68 : 64;
    g.row0 = 0; g.splitk = 0; g.sctx = 0; g.xctx = 0; g.auxc = nullptr; g.aux = P1; g.gm = mod; g.rope = (const float*)(ws + OFF_ROPE);
    g.xin_lat = p.out; g.xin_ctx = (const float*)(ws + OFF_XC); g.xout_lat = p.out; g.xout_ctx = (float*)(ws + OFF_XC);
    g.out = P1; g.ldc = 1024; g.lda = 1024; g.ldb = 1024; g.K = 1024;
    switch (sub) {
    case 1:
        if (gi) return false;
        g.A = H; g.Bt = WinT; g.nM = 68; g.nN = 5; g.mode = M_P1; g.ldc = P1LD;
        if (l == 0) { g.sctx = 1; g.xctx = 12; g.auxc = (bf16_t*)(ws + OFF_GC); }
        return true;
    case 3:
        g.nM = mt; g.nN = 4;
        if (gi == 0 || gi == 2 || gi == 4) { g.A = H; g.Bt = WinT + (size_t)(1280 + 512 * gi) * 1024; g.mode = M_GATE; g.out = P1; g.nM = 64; return true; }
        if (l == 0) { g.sctx = 1; g.auxc = (bf16_t*)(ws + OFF_GC) + ((gi - 1) >> 1) * 1024; }
        g.out = YM; g.lda = 1280; g.ldb = 1280;
        if (gi == 1) { g.A = AM; g.Bt = WmT; g.K = 512; g.mode = M_YSET; return true; }
        if (gi == 3) { g.A = AM + 512; g.Bt = WmT + 512; g.K = 256; g.mode = M_YADD; return true; }
        if (gi == 5) { g.A = AM + 768; g.Bt = WmT + 768; g.K = 512; g.mode = M_YADD; return true; }
        return false;
    case 4:
        if (gi) return false;
        g.A = YM; g.Bt = WoT; g.nM = mt; g.nN = 4; g.mode = M_RES; g.gm = mod + 2048;
        if (l == 0) { g.xin_lat = p.x; g.xin_ctx = p.ctx; }
        return true;
    case 6:
        if (gi) return false;
        g.A = H; g.Bt = WupT; g.nM = mt; g.nN = 22; g.mode = M_UPC; g.out = (bf16_t*)(ws + OFF_ACT); g.ldc = DFF; g.aux = (const bf16_t*)(ws + OFF_HB);
        g.cw = lp->conv_w + (size_t)l * 3 * 5632;
        return true;
    case 8:
        if (gi > 1 || (gi == 1 && l != 0)) return false;
        g.A = (const bf16_t*)(ws + OFF_ACT); g.lda = DFF; g.Bt = WdT; g.ldb = DFF; g.K = DFF; g.nM = 64; g.nN = 4; g.mode = M_RES; g.gm = mod + 5120;
        if (gi == 1) { g.splitk = 1; g.K = SK_NT * BK; }
        return true;
    }
    return false;
}


__device__ __forceinline__ bool gemm_phase(LAS unsigned char* lds, int l, int sub, int gi, bool dry = false) {
    GD g; if (!make_gd((LAS const Params*)(lds + PRM_OFF), l, sub, gi, g)) return false;
    g.A = uptr(g.A); g.Bt = uptr(g.Bt); g.lda = __builtin_amdgcn_readfirstlane(g.lda); g.ldb = __builtin_amdgcn_readfirstlane(g.ldb); g.K = __builtin_amdgcn_readfirstlane(g.K);
    g.nM = __builtin_amdgcn_readfirstlane(g.nM); g.splitk = __builtin_amdgcn_readfirstlane(g.splitk); g.xctx = __builtin_amdgcn_readfirstlane(g.xctx); g.sctx = __builtin_amdgcn_readfirstlane(g.sctx); g.nN = __builtin_amdgcn_readfirstlane(g.nN); g.mode = __builtin_amdgcn_readfirstlane(g.mode);
    if (sub == 1) {
        GAS const u32x4* rt = (GAS const u32x4*)(unsigned long long)(((LAS const Params*)(lds + PRM_OFF))->ws + OFF_ROPE);
        const int t0 = otid();
        *(LAS u32x4*)(lds + 139264 + t0 * 16) = rt[t0];
    }
    if (sub == 8) {
        LAS const Params* lp = (LAS const Params*)(lds + PRM_OFF);
        unsigned char* ws = lp->ws; const float* cwp = lp->conv_w + (size_t)l * 3 * 5632;
        Unit fu;
        for (int i = 0; unit_next(g, i, fu); ++i) fixup_tile((const bf16_t*)(ws + OFF_HB), (bf16_t*)(ws + OFF_ACT), cwp, fu.pm);
        asm volatile("s_waitcnt vmcnt(0)" ::: "memory");
        __syncthreads();
    }
    const int tid = otid(), wid = __builtin_amdgcn_readfirstlane(tid >> 6), lane = tid & 63, wr = wid >> 2, wc = wid & 3, fr = lane & 15, fq = lane >> 4;
    const int K = g.K, nt = K / BK;
    const bool perm = (g.mode != M_RES);
    unsigned voffA[2], voffB[2];
#pragma unroll
    for (int i = 0; i < 2; ++i) { int R, C; stage_rc(tid * 16 + i * 8192, R, C); const int Rb = perm ? ((R & ~31) + perm32(R & 31)) : R;
        const int Ra = (g.mode == M_UPC) ? ((R & ~63) + 4 * (R & 15) + ((R >> 4) & 3)) : R;
        voffA[i] = (unsigned)(Ra * g.lda + C) * 2u; voffB[i] = (unsigned)(Rb * g.ldb + C) * 2u; }
    const size_t kstep = (size_t)(BK * 2);
    const size_t hstepA = (size_t)HALF * g.lda * 2, hstepB = (size_t)HALF * g.ldb * 2;
    const size_t tstepA = 2 * hstepA, tstepB = 2 * hstepB;
    const unsigned ldsw = (unsigned)wid * 1024u;
    const int aoff = lds_byte(wr * 64 + fr, fq * 8), boff = lds_byte(wc * 32 + fr, fq * 8);
#define PG8_SA(b, h) (((b) * 2 + (h)) * HTB)
#define PG8_SB(b, h) ((4 + (b) * 2 + (h)) * HTB)
#define PG8_STAGE(bufoff, gbase, voff) do { _Pragma("unroll") for (int _i = 0; _i < 2; ++_i) \
        __builtin_amdgcn_global_load_lds((const unsigned*)((const char*)(gbase) + (voff)[_i]), (LAS unsigned*)(lds + (bufoff) + ldsw + _i * 8192), 16, 0, 0); } while (0)
#define PG8_LDA(dst, b, h) do { _Pragma("unroll") for (int m = 0; m < 4; ++m) _Pragma("unroll") for (int k = 0; k < 2; ++k) dst[m][k] = *(const LAS bf16x8*)(lds + PG8_SA(b, h) + aoff + m * 2048 + k * 1024); } while (0)
#define PG8_LDB(dst, b, h) do { _Pragma("unroll") for (int n = 0; n < 2; ++n) _Pragma("unroll") for (int k = 0; k < 2; ++k) dst[n][k] = *(const LAS bf16x8*)(lds + PG8_SB(b, h) + boff + n * 2048 + k * 1024); } while (0)
#define PG8_MMA(ai, bj, At, Bt) do { __builtin_amdgcn_s_setprio(1); _Pragma("unroll") for (int m = 0; m < 4; ++m) _Pragma("unroll") for (int n = 0; n < 2; ++n) _Pragma("unroll") for (int k = 0; k < 2; ++k) \
        acc[ai][bj][m][n] = __builtin_amdgcn_mfma_f32_16x16x32_bf16(Bt[n][k], At[m][k], acc[ai][bj][m][n], 0, 0, 0); __builtin_amdgcn_s_setprio(0); } while (0)
#define PG8_WAIT_V(n) asm volatile("s_waitcnt vmcnt(" #n ")" ::: "memory")
#define PG8_WAIT_L(n) asm volatile("s_waitcnt lgkmcnt(" #n ")" ::: "memory")
#define PG8_BAR __builtin_amdgcn_s_barrier()
#define PG8_SCHED __builtin_amdgcn_sched_barrier(0)
    Unit cur, nxt; int ui = 0;
    if (!unit_next(g, 0, cur)) return true;
    f32x4 acc[2][2][4][2];
#pragma unroll
    for (int a = 0; a < 2; ++a)
#pragma unroll
        for (int b = 0; b < 2; ++b)
#pragma unroll
            for (int m = 0; m < 4; ++m)
#pragma unroll
                for (int n = 0; n < 2; ++n) acc[a][b][m][n] = (f32x4){0.f, 0.f, 0.f, 0.f};
    bf16x8 At[4][2], B0[2][2], B1[2][2];
    const char* cA = (const char*)g.A + (size_t)cur.pm * tstepA + (size_t)cur.k0 * kstep; const char* cB = (const char*)g.Bt + (size_t)cur.pn * tstepB + (size_t)cur.k0 * kstep;
    PG8_STAGE(PG8_SB(0, 0), cB, voffB); PG8_STAGE(PG8_SA(0, 0), cA, voffA); PG8_STAGE(PG8_SB(0, 1), cB + hstepB, voffB); PG8_STAGE(PG8_SA(0, 1), cA + hstepA, voffA);
    if (wr == 1) PG8_BAR;
    PG8_WAIT_V(4); PG8_BAR;
    PG8_STAGE(PG8_SB(1, 0), cB + kstep, voffB); PG8_STAGE(PG8_SA(1, 0), cA + kstep, voffA); PG8_STAGE(PG8_SB(1, 1), cB + hstepB + kstep, voffB);
    PG8_WAIT_V(6); PG8_BAR;
    for (;;) {
        const bool has_next = unit_next(g, ui + 1, nxt);
        const char* nA = has_next ? (const char*)g.A + (size_t)nxt.pm * tstepA + (size_t)nxt.k0 * kstep : cA; const char* nB = has_next ? (const char*)g.Bt + (size_t)nxt.pn * tstepB + (size_t)nxt.k0 * kstep : cB;
        for (int t = 0; t < nt; t += 2) {
            const bool last = (t == nt - 2);
            const char* a1 = cA + (size_t)(t + 1) * kstep;
            const char* a2 = last ? nA : cA + (size_t)(t + 2) * kstep; const char* b2 = last ? nB : cB + (size_t)(t + 2) * kstep;
            const char* a3 = a2 + kstep; const char* b3 = b2 + kstep;
            PG8_LDB(B0, 0, 0); PG8_SCHED; PG8_LDA(At, 0, 0); PG8_STAGE(PG8_SA(1, 1), a1 + hstepA, voffA);
            PG8_WAIT_L(8); PG8_BAR; PG8_WAIT_L(0); PG8_MMA(0, 0, At, B0); PG8_BAR; PG8_SCHED;
            PG8_LDB(B1, 0, 1); PG8_STAGE(PG8_SB(0, 0), b2, voffB);
            PG8_BAR; PG8_WAIT_L(0); PG8_MMA(0, 1, At, B1); PG8_BAR;
            PG8_LDA(At, 0, 1); PG8_STAGE(PG8_SA(0, 0), a2, voffA);
            PG8_BAR; PG8_WAIT_L(0); PG8_MMA(1, 0, At, B0); PG8_BAR; PG8_SCHED;
            PG8_STAGE(PG8_SB(0, 1), b2 + hstepB, voffB);
            PG8_WAIT_V(6); PG8_BAR; PG8_MMA(1, 1, At, B1); PG8_BAR;
            PG8_LDB(B0, 1, 0); PG8_SCHED; PG8_LDA(At, 1, 0); PG8_STAGE(PG8_SA(0, 1), a2 + hstepA, voffA);
            PG8_WAIT_L(8); PG8_BAR; PG8_WAIT_L(0); PG8_MMA(0, 0, At, B0); PG8_BAR; PG8_SCHED;
            PG8_LDB(B1, 1, 1); PG8_STAGE(PG8_SB(1, 0), b3, voffB);
            PG8_BAR; PG8_WAIT_L(0); PG8_MMA(0, 1, At, B1); PG8_BAR;
            PG8_LDA(At, 1, 1); PG8_STAGE(PG8_SA(1, 0), a3, voffA);
            PG8_BAR; PG8_WAIT_L(0); PG8_MMA(1, 0, At, B0); PG8_BAR; PG8_SCHED;
            PG8_STAGE(PG8_SB(1, 1), b3 + hstepB, voffB);
            PG8_WAIT_V(6); PG8_BAR; PG8_MMA(1, 1, At, B1); PG8_BAR;
        }
        __builtin_amdgcn_sched_barrier(0); asm volatile("" ::: "memory");
        if (!dry) { GD g2; make_gd((LAS const Params*)(lds + PRM_OFF), l, sub, gi, g2); gemm_epilogue(lds, g2, acc, cur); }
        if (!has_next) break;
#pragma unroll
        for (int a = 0; a < 2; ++a)
#pragma unroll
            for (int b = 0; b < 2; ++b)
#pragma unroll
                for (int m = 0; m < 4; ++m)
#pragma unroll
                    for (int n = 0; n < 2; ++n) acc[a][b][m][n] = (f32x4){0.f, 0.f, 0.f, 0.f};
        cur = nxt; cA = nA; cB = nB; ++ui;
    }
    PG8_WAIT_V(0);
    if (wr == 0) PG8_BAR;
    PG8_BAR;
    return true;
#undef PG8_SA
#undef PG8_SB
#undef PG8_STAGE
#undef PG8_LDA
#undef PG8_LDB
#undef PG8_MMA
#undef PG8_WAIT_V
#undef PG8_WAIT_L
#undef PG8_BAR
#undef PG8_SCHED
}

__device__ __forceinline__ void transpose_tile(const float* W, int N, bf16_t* WT, int ldd, int kb, int nb, int upmap, LAS float* scr) {
    const int tid = otid(), k0 = kb * 64, n0 = nb * 256;
    GAS const float* src = (GAS const float*)(unsigned long long)W + (size_t)k0 * N + n0;
    float tv[32];
#pragma unroll
    for (int i = 0; i < 32; ++i) { const int kk = i * 2 + (tid >> 8), nn = tid & 255; tv[i] = src[(size_t)kk * N + nn]; }
    asm volatile("" ::: "memory");
#pragma unroll
    for (int i = 0; i < 32; ++i) { const int kk = i * 2 + (tid >> 8), nn = tid & 255; scr[kk * 257 + nn] = tv[i]; }
    __syncthreads();
    const int c = tid & 7;
    GAS bf16_t* dst = (GAS bf16_t*)(unsigned long long)WT;
#pragma unroll
    for (int q = 0; q < 4; ++q) {
        const int n = (tid >> 3) + 64 * q; const LAS float* sp = scr + (8 * c) * 257 + n;
        u32x4 o; o.x = pk2(sp[0], sp[257]); o.y = pk2(sp[514], sp[771]); o.z = pk2(sp[1028], sp[1285]); o.w = pk2(sp[1542], sp[1799]);
        int nd = n0 + n;
        if (upmap) { nd = (nd < DFF) ? (256 * (nd >> 7) + (nd & 127)) : (256 * ((nd - DFF) >> 7) + 128 + ((nd - DFF) & 127)); }
        *(GAS u32x4*)(dst + (size_t)nd * ldd + k0 + 8 * c) = o;
    }
    __syncthreads();
}

__device__ void phase_prep(const Params& p, LAS unsigned char* lds) {
    const int tid = otid();
    LAS float* scr = (LAS float*)lds;
    constexpr int T_IN = 16 * 17, T_BA = 8 * 4, T_WO = 16 * 4, T_UP = 16 * 22, T_DN = 44 * 4, T_L = T_IN + T_BA + T_WO + T_UP + T_DN;
    constexpr int I_TR = 2 * T_L, I_POOL = I_TR + 128, I_FOUR = I_POOL + 256, I_MOD = I_FOUR + 192, I_ALL = I_MOD + 1;
    for (int prep_rep = 0; prep_rep < ((PROBE >= 301 && PROBE <= 304) ? 2 : 1); ++prep_rep)
    for (int it = blockIdx.x; it < I_ALL; it += gridDim.x) {
#if PROBE >= 301 && PROBE <= 304
        if (prep_rep == 1) { const int cls = (it < I_TR) ? 301 : (it < I_FOUR) ? 302 : (it < I_MOD) ? 303 : 304; if (cls != PROBE) continue; }
#endif
        if (it < I_TR) {
            const int l = it / T_L; int j = it % T_L;
            unsigned char* wb = p.ws + OFF_W + (size_t)l * LW;
            if (j < T_IN) transpose_tile(p.w_in + (size_t)l * 1024 * INW, INW, (bf16_t*)(wb + LW_WIN), 1024, j / 17, j % 17, 0, scr);
            else if ((j -= T_IN) < T_BA) transpose_tile(p.w_br_attn + (size_t)l * 512 * 1024, 1024, (bf16_t*)(wb + LW_WM), 1280, j / 4, j % 4, 0, scr);
            else if ((j -= T_BA) < T_WO) transpose_tile(p.w_out + (size_t)l * 1024 * 1024, 1024, (bf16_t*)(wb + LW_WO), 1024, j / 4, j % 4, 0, scr);
            else if ((j -= T_WO) < T_UP) transpose_tile(p.w_up + (size_t)l * 1024 * 5632, 5632, (bf16_t*)(wb + LW_WUP), 1024, j / 22, j % 22, 1, scr);
            else { j -= T_UP; transpose_tile(p.w_down + (size_t)l * DFF * 1024, 1024, (bf16_t*)(wb + LW_WD), DFF, j / 4, j % 4, 0, scr); }
        } else if (it < I_POOL) {
            const int j = it - I_TR, l = j >> 6, g = (j >> 4) & 3, nb = j & 15;
            const int n = nb * 64 + (tid & 63), co = tid >> 6;
            const float* pw = p.pool_w + (size_t)l * 16384 + g * 4096 + (8 * co) * 64;
            const float* sc = p.pool_scale + l * 256 + g * 64;
            const float* wb = p.w_br_pool + (size_t)l * 256 * 1024 + (size_t)(g * 64) * 1024 + n;
            float a[8];
#pragma unroll
            for (int q = 0; q < 8; ++q) a[q] = 0.f;
#pragma unroll 1
            for (int d0 = 0; d0 < 64; d0 += 16) {
                float wv[16];
#pragma unroll
                for (int dd = 0; dd < 16; ++dd) wv[dd] = ((GAS const float*)(unsigned long long)wb)[(size_t)(d0 + dd) * 1024];
                asm volatile("" ::: "memory");
#pragma unroll
                for (int dd = 0; dd < 16; ++dd) { const float w = sc[d0 + dd] * wv[dd];
#pragma unroll
                    for (int q = 0; q < 8; ++q) a[q] += pw[q * 64 + d0 + dd] * w; }
            }
            bf16_t* dst = (bf16_t*)(p.ws + OFF_W + (size_t)l * LW + LW_WM) + (size_t)n * 1280 + 512 + g * 64 + 8 * co;
            u32x4 o; o.x = pk2(a[0], a[1]); o.y = pk2(a[2], a[3]); o.z = pk2(a[4], a[5]); o.w = pk2(a[6], a[7]);
            *(u32x4*)dst = o;
        } else if (it < I_FOUR) {
            const int j = it - I_POOL, l = j >> 7, g = (j >> 5) & 3, nb = (j >> 1) & 15, part = j & 1;
            if (tid < 64) { float sv, cv; sincospif((float)tid / 32.f, &sv, &cv); scr[tid] = part ? sv : cv; }
            __syncthreads();
            const int n = nb * 64 + (tid & 63), co = tid >> 6;
            const float* wb = p.w_br_four + (size_t)l * 256 * 1024 + (size_t)(g * 64) * 1024 + n;
            float a[8];
#pragma unroll
            for (int q = 0; q < 8; ++q) a[q] = 0.f;
#pragma unroll 1
            for (int m0 = 0; m0 < 64; m0 += 16) {
                float wv[16];
#pragma unroll
                for (int dd = 0; dd < 16; ++dd) wv[dd] = ((GAS const float*)(unsigned long long)wb)[(size_t)(m0 + dd) * 1024];
                asm volatile("" ::: "memory");
#pragma unroll
                for (int dd = 0; dd < 16; ++dd) { const int m = m0 + dd; const float w = wv[dd];
#pragma unroll
                    for (int q = 0; q < 8; ++q) a[q] += scr[(m * (8 * co + q)) & 63] * w; }
            }
            bf16_t* dst = (bf16_t*)(p.ws + OFF_W + (size_t)l * LW + LW_WM) + (size_t)n * 1280 + 768 + g * 128 + part * 64 + 8 * co;
            u32x4 o; o.x = pk2(a[0], a[1]); o.y = pk2(a[2], a[3]); o.z = pk2(a[4], a[5]); o.w = pk2(a[6], a[7]);
            *(u32x4*)dst = o;
            __syncthreads();
        } else if (it < I_MOD) {
            const int j = it - I_FOUR, l = j / 96, cb = j % 96;
            for (int i = tid; i < 5 * 1024; i += 512) { const int r = i >> 10, k = i & 1023; const float v = (r < 4) ? p.c[r * 1024 + k] : p.c_ctx[k]; scr[i] = v / (1.f + __expf(-v)); }
            __syncthreads();
            const int col = cb * 64 + (tid & 63), ks = tid >> 6;
            GAS const float* wm = (GAS const float*)(unsigned long long)p.w_mod + (size_t)l * 1024 * 6144 + col;
            float a0 = 0.f, a1 = 0.f, a2 = 0.f, a3 = 0.f, a4 = 0.f;
#pragma unroll 1
            for (int k0 = ks * 128; k0 < ks * 128 + 128; k0 += 32) {
                float wv[32];
#pragma unroll
                for (int q = 0; q < 32; ++q) wv[q] = wm[(size_t)(k0 + q) * 6144];
                asm volatile("" ::: "memory");
#pragma unroll
                for (int q = 0; q < 32; ++q) { const int k = k0 + q; const float w = wv[q];
                    a0 += scr[k] * w; a1 += scr[1024 + k] * w; a2 += scr[2048 + k] * w; a3 += scr[3072 + k] * w; a4 += scr[4096 + k] * w; }
            }
            __syncthreads();
            LAS float* part = scr + 5120;
            part[(ks * 5 + 0) * 64 + (tid & 63)] = a0; part[(ks * 5 + 1) * 64 + (tid & 63)] = a1; part[(ks * 5 + 2) * 64 + (tid & 63)] = a2;
            part[(ks * 5 + 3) * 64 + (tid & 63)] = a3; part[(ks * 5 + 4) * 64 + (tid & 63)] = a4;
            __syncthreads();
            if (tid < 320) { const int r = tid >> 6, cc = tid & 63; float s = p.b_mod[l * 6144 + cb * 64 + cc];
#pragma unroll
                for (int q = 0; q < 8; ++q) s += part[(q * 5 + r) * 64 + cc];
                ((float*)(p.ws + OFF_MOD))[(size_t)(l * 5 + r) * 6144 + cb * 64 + cc] = s; }
            __syncthreads();
        } else {
            float* rope = (float*)(p.ws + OFF_ROPE); float* tw = (float*)(p.ws + OFF_TW);
            for (int i = tid; i < 1024; i += 512) { const int pos = i >> 4, f = i & 15; const float inv = powf(10000.f, -(float)f / 16.f); const float ang = (float)pos * inv;
                rope[2 * i] = cosf(ang); rope[2 * i + 1] = sinf(ang); }
            for (int i = tid; i < 4095; i += 512) { const int sh = 31 - __clz(i + 1), half = 1 << sh, j = i + 1 - half; float sv, cv; sincospif((float)j / (float)half, &sv, &cv); tw[2 * i] = cv; tw[2 * i + 1] = sv; }
        }
    }
}

__device__ void phase_norm(const Params& p, int l, int which) {
    const int tid = otid(), lane = tid & 63, gw = blockIdx.x * 8 + (tid >> 6), nw = gridDim.x * 8;
    const int nrows = (l == 1 && which == 1) ? NL : NR;
    const bool first = (l == 0 && which == 0);
    GAS const f32x4* gn = (GAS const f32x4*)(unsigned long long)((which ? p.norm_ffn : p.norm_mix) + l * 1024);
    GAS const float* mod = (GAS const float*)(unsigned long long)(p.ws + OFF_MOD) + (size_t)l * 5 * 6144 + (which ? 3072 : 0);
    GAS bf16_t* H = (GAS bf16_t*)(unsigned long long)(p.ws + OFF_H);
    for (int row = gw; row < nrows; row += nw) {
        GAS const f32x4* xr; int rb;
        if (row < NL) { xr = (GAS const f32x4*)(unsigned long long)((first ? p.x : p.out) + (size_t)row * DM); rb = row >> 12; }
        else { xr = (GAS const f32x4*)(unsigned long long)((first ? p.ctx : (const float*)(p.ws + OFF_XC)) + (size_t)(row - NL) * DM); rb = 4; }
        GAS const f32x4* sh = (GAS const f32x4*)(mod + rb * 6144); GAS const f32x4* sc = (GAS const f32x4*)(mod + rb * 6144 + 1024);
        f32x4 v[4], g4[4], s4[4], h4[4];
#pragma unroll
        for (int j = 0; j < 4; ++j) { v[j] = xr[lane + 64 * j]; g4[j] = gn[lane + 64 * j]; s4[j] = sc[lane + 64 * j]; h4[j] = sh[lane + 64 * j]; }
        asm volatile("" ::: "memory");
        if (l == 1 && which == 0 && row >= NL) {
            GAS const f32x4* pp = (GAS const f32x4*)(unsigned long long)((const float*)(p.ws + OFF_PART) + (size_t)(row - NL) * DM);
#pragma unroll 1
            for (int ks = 0; ks < SK_S; ++ks) {
                f32x4 t[4];
#pragma unroll
                for (int j = 0; j < 4; ++j) t[j] = pp[(size_t)ks * (1024 * DM / 4) + lane + 64 * j];
                asm volatile("" ::: "memory");
#pragma unroll
                for (int j = 0; j < 4; ++j) v[j] += t[j];
            }
        }
        float s = 0.f;
#pragma unroll
        for (int j = 0; j < 4; ++j) s += (v[j].x * v[j].x + v[j].y * v[j].y) + (v[j].z * v[j].z + v[j].w * v[j].w);
        const float rstd = rsqrtf(wave_sum(s) * (1.f / 1024.f) + 1e-6f);
#pragma unroll
        for (int j = 0; j < 4; ++j) {
            const f32x4 y = v[j] * rstd * g4[j] * (s4[j] + 1.f) + h4[j];
            u32x2 o; o.x = pk2(y.x, y.y); o.y = pk2(y.z, y.w);
            ((GAS u32x2*)(H + (size_t)row * DM))[lane + 64 * j] = o;
        }
    }
}

__device__ void phase_final(const Params& p) {
    const int tid = otid(), lane = tid & 63, gw = blockIdx.x * 8 + (tid >> 6), nw = gridDim.x * 8;
    GAS const f32x4* gf = (GAS const f32x4*)(unsigned long long)p.norm_final;
    for (int row = gw; row < NL; row += nw) {
        GAS f32x4* xr = (GAS f32x4*)(unsigned long long)(p.out + (size_t)row * DM);
        f32x4 v[4], g4[4];
#pragma unroll
        for (int j = 0; j < 4; ++j) { v[j] = xr[lane + 64 * j]; g4[j] = gf[lane + 64 * j]; }
        asm volatile("" ::: "memory");
        float s = 0.f;
#pragma unroll
        for (int j = 0; j < 4; ++j) s += (v[j].x * v[j].x + v[j].y * v[j].y) + (v[j].z * v[j].z + v[j].w * v[j].w);
        const float rstd = rsqrtf(wave_sum(s) * (1.f / 1024.f) + 1e-6f);
#pragma unroll
        for (int j = 0; j < 4; ++j) xr[lane + 64 * j] = v[j] * rstd * g4[j];
    }
}

constexpr int KPITCH = 144, VPITCH = 272;
__device__ void attn_item(const Params& p, int l, int item, LAS unsigned char* lds) {
    const int tid = otid(), wid = __builtin_amdgcn_readfirstlane(tid >> 6), lane = tid & 63, l31 = lane & 31, hi = lane >> 5;
    const bool isctx = item >= 512;
    int b, n, h, hb, qrow0;
    if (!isctx) { b = item >> 7; n = (item >> 2) & 31; h = (item >> 1) & 1; hb = item & 1; qrow0 = b * 4096 + n * 128; }
    else { const int j = item - 512; b = j >> 3; n = (j >> 2) & 1; h = (j >> 1) & 1; hb = j & 1; qrow0 = NL + b * 256 + n * 128; }
    const bf16_t* P1 = (const bf16_t*)(p.ws + OFF_P1);
    bf16_t* AM = (bf16_t*)(p.ws + OFF_AM);
    LAS unsigned char* Kl = lds; LAS unsigned char* Vt = lds + 128 * KPITCH;
    const int g = wid >> 1, head = 4 * h + g, qq = 64 * hb + 32 * (wid & 1) + l31;
    bf16x8 qf[4];
#pragma unroll
    for (int ks = 0; ks < 4; ++ks) {
        const u32x4 w = *(const u32x4*)(P1 + (size_t)(qrow0 + qq) * P1LD + 256 + head * 64 + 16 * ks + 8 * hi);
        u32x4 o; o.x = pk2(bflo(w.x) * 0.125f, bfhi(w.x) * 0.125f); o.y = pk2(bflo(w.y) * 0.125f, bfhi(w.y) * 0.125f);
        o.z = pk2(bflo(w.z) * 0.125f, bfhi(w.z) * 0.125f); o.w = pk2(bflo(w.w) * 0.125f, bfhi(w.w) * 0.125f);
        qf[ks] = __builtin_bit_cast(bf16x8, o);
    }
    f32x16 ot[2];
    float mrun = -1e30f, lrun = 0.f;
#pragma unroll
    for (int dt = 0; dt < 2; ++dt)
#pragma unroll
        for (int r = 0; r < 16; ++r) ot[dt][r] = 0.f;
    GAS const bf16_t* P1g = (GAS const bf16_t*)(unsigned long long)P1;
    const int pr = tid & 63, vslab = tid >> 6;
#define ATT_NEXT(c_) ({ int _c = (c_) + 1; if (!isctx) { if (_c == 1 && n == 0) _c = 2; if (_c == 2 && n == 31) _c = 3; } _c; })
#define ATT_KBASE(c_) ((c_) == 0 ? qrow0 : (c_) == 1 ? qrow0 - 128 : (c_) == 2 ? qrow0 + 128 : NL + b * 256 + ((c_) - 3) * 128)
    u32x4 kw[2], w0, w1;
    {
        const int kb0 = ATT_KBASE(isctx ? 3 : 0);
#pragma unroll
        for (int i = 0; i < 2; ++i) { const int q = tid + 512 * i, key = q >> 3, slab = q & 7;
            kw[i] = *(GAS const u32x4*)(P1g + (size_t)(kb0 + key) * P1LD + 64 * h + 8 * slab); }
        w0 = *(GAS const u32x4*)(P1g + (size_t)(kb0 + 2 * pr) * P1LD + 128 + 64 * h + 8 * vslab);
        w1 = *(GAS const u32x4*)(P1g + (size_t)(kb0 + 2 * pr + 1) * P1LD + 128 + 64 * h + 8 * vslab);
    }
#pragma unroll 1
    for (int ci = isctx ? 3 : 0; ci < 5; ci = ATT_NEXT(ci)) {
        const int mask = (ci == 1) ? 1 : (ci == 2) ? 2 : 0;
        asm volatile("" ::: "memory");
        __syncthreads();
        {
#pragma unroll
            for (int i = 0; i < 2; ++i) { const int q = tid + 512 * i, key = q >> 3, slab = q & 7; *(LAS u32x4*)(Kl + key * KPITCH + 16 * slab) = kw[i]; }
            LAS unsigned char* vb = Vt + (8 * vslab) * VPITCH + 4 * pr;
            *(LAS unsigned*)(vb + 0 * VPITCH) = (w0.x & 0xffffu) | (w1.x << 16); *(LAS unsigned*)(vb + 1 * VPITCH) = (w0.x >> 16) | (w1.x & 0xffff0000u);
            *(LAS unsigned*)(vb + 2 * VPITCH) = (w0.y & 0xffffu) | (w1.y << 16); *(LAS unsigned*)(vb + 3 * VPITCH) = (w0.y >> 16) | (w1.y & 0xffff0000u);
            *(LAS unsigned*)(vb + 4 * VPITCH) = (w0.z & 0xffffu) | (w1.z << 16); *(LAS unsigned*)(vb + 5 * VPITCH) = (w0.z >> 16) | (w1.z & 0xffff0000u);
            *(LAS unsigned*)(vb + 6 * VPITCH) = (w0.w & 0xffffu) | (w1.w << 16); *(LAS unsigned*)(vb + 7 * VPITCH) = (w0.w >> 16) | (w1.w & 0xffff0000u);
        }
        __syncthreads();
        {
            const int cn = ATT_NEXT(ci);
            if (cn < 5) {
                const int kbn = ATT_KBASE(cn);
#pragma unroll
                for (int i = 0; i < 2; ++i) { const int q = tid + 512 * i, key = q >> 3, slab = q & 7;
                    kw[i] = *(GAS const u32x4*)(P1g + (size_t)(kbn + key) * P1LD + 64 * h + 8 * slab); }
                w0 = *(GAS const u32x4*)(P1g + (size_t)(kbn + 2 * pr) * P1LD + 128 + 64 * h + 8 * vslab);
                w1 = *(GAS const u32x4*)(P1g + (size_t)(kbn + 2 * pr + 1) * P1LD + 128 + 64 * h + 8 * vslab);
            }
            asm volatile("" ::: "memory");
        }
        f32x16 st[4];
#pragma unroll
        for (int kt = 0; kt < 4; ++kt) {
#pragma unroll
            for (int r = 0; r < 16; ++r) st[kt][r] = 0.f;
#pragma unroll
            for (int ks = 0; ks < 4; ++ks) {
                const bf16x8 kf = *(const LAS bf16x8*)(Kl + (32 * kt + l31) * KPITCH + 32 * ks + 16 * hi);
                st[kt] = __builtin_amdgcn_mfma_f32_32x32x16_bf16(kf, qf[ks], st[kt], 0, 0, 0);
            }
        }
        __builtin_amdgcn_sched_barrier(0);
        float mx = -1e30f;
        if (mask) {
            int klo = (mask == 1) ? qq : -1, khi = (mask == 2) ? qq : 1000;
            asm volatile("" : "+v"(klo), "+v"(khi));
#pragma unroll
            for (int kt = 0; kt < 4; ++kt)
#pragma unroll
                for (int r = 0; r < 16; ++r) {
                    const int kk = 32 * kt + 8 * (r >> 2) + 4 * hi + (r & 3);
                    st[kt][r] = (kk >= klo && kk <= khi) ? st[kt][r] : -1e30f;
                }
        }
#pragma unroll
        for (int kt = 0; kt < 4; ++kt)
#pragma unroll
            for (int r = 0; r < 16; ++r) mx = fmaxf(mx, st[kt][r]);
        mx = fmaxf(mx, __shfl_xor(mx, 32)) * LOG2E;
        const float mnew = fmaxf(mrun, mx), alpha = __builtin_amdgcn_exp2f(mrun - mnew);
        float rs = 0.f;
        __builtin_amdgcn_sched_barrier(0);
#pragma unroll
        for (int kt = 0; kt < 4; ++kt)
#pragma unroll
            for (int r = 0; r < 16; ++r) { const float e = __builtin_amdgcn_exp2f(fmaf(st[kt][r], LOG2E, -mnew)); st[kt][r] = e; rs += e; }
        rs += __shfl_xor(rs, 32);
        lrun = lrun * alpha + rs; mrun = mnew;
#pragma unroll
        for (int dt = 0; dt < 2; ++dt)
#pragma unroll
            for (int r = 0; r < 16; ++r) ot[dt][r] *= alpha;
#pragma unroll
        for (int kt = 0; kt < 4; ++kt)
#pragma unroll
            for (int s = 0; s < 2; ++s) {
                __builtin_amdgcn_sched_barrier(0);
                u32x4 pw; pw.x = pk2(st[kt][8 * s + 0], st[kt][8 * s + 1]); pw.y = pk2(st[kt][8 * s + 2], st[kt][8 * s + 3]);
                pw.z = pk2(st[kt][8 * s + 4], st[kt][8 * s + 5]); pw.w = pk2(st[kt][8 * s + 6], st[kt][8 * s + 7]);
                const bf16x8 pf = __builtin_bit_cast(bf16x8, pw);
#pragma unroll
                for (int dt = 0; dt < 2; ++dt) {
                    const LAS unsigned char* va = Vt + (32 * dt + l31) * VPITCH + (32 * kt + 16 * s + 4 * hi) * 2;
                    const u32x2 a0 = *(const LAS u32x2*)va, a1 = *(const LAS u32x2*)(va + 16);
                    u32x4 aw; aw.x = a0.x; aw.y = a0.y; aw.z = a1.x; aw.w = a1.y;
                    ot[dt] = __builtin_amdgcn_mfma_f32_32x32x16_bf16(__builtin_bit_cast(bf16x8, aw), pf, ot[dt], 0, 0, 0);
                }
            }
    }
    const float sink = p.attn_sink[l * 8 + head] * LOG2E;
    const float inv = 1.f / (lrun + __builtin_amdgcn_exp2f(sink - mrun));
    bf16_t* orow = AM + (size_t)(qrow0 + qq) * 1280 + head * 64;
#pragma unroll
    for (int dt = 0; dt < 2; ++dt)
#pragma unroll
        for (int rq = 0; rq < 4; ++rq) {
            u32x2 o; o.x = pk2(ot[dt][4 * rq] * inv, ot[dt][4 * rq + 1] * inv); o.y = pk2(ot[dt][4 * rq + 2] * inv, ot[dt][4 * rq + 3] * inv);
            *(u32x2*)(orow + 32 * dt + 8 * rq + 4 * hi) = o;
        }
}

__device__ void fft_item(const Params& p, int item, bool isctx, LAS unsigned char* lds) {
    const int tid = otid();
    const int b = item >> 6, quad = item & 63;
    const int logN = isctx ? 8 : 12, N = 1 << logN;
    const int rowbase = isctx ? NL + b * 256 : b * 4096;
    LAS f32x2* data = (LAS f32x2*)lds;
    LAS f32x2* tw = (LAS f32x2*)(lds + 65536);
    __syncthreads();
    {
        GAS const bf16_t* src = (GAS const bf16_t*)(unsigned long long)(p.ws + OFF_P1) + (size_t)rowbase * P1LD + 1024 + quad * 4;
        u32x2 v[8];
#pragma unroll
        for (int q = 0; q < 8; ++q) { const int t = tid + 512 * q; v[q] = (t < N) ? *(GAS const u32x2*)(src + (size_t)t * P1LD) : (u32x2){0u, 0u}; }
        asm volatile("" ::: "memory");
#pragma unroll
        for (int q = 0; q < 8; ++q) { const int t = tid + 512 * q;
            if (t < N) { f32x2 a; a.x = bflo(v[q].x); a.y = bfhi(v[q].x); data[t] = a; f32x2 c; c.x = bflo(v[q].y); c.y = bfhi(v[q].y); data[N + t] = c; } }
    }
    __syncthreads();
    for (int sh = logN - 1; sh >= 1; sh -= 2) {
        const int q = 1 << (sh - 1), ng = 2 << (logN - 2);
        const LAS f32x2* tw1 = tw + (2 * q - 1);
        const LAS f32x2* tw2 = tw + (q - 1);
#pragma unroll 2
        for (int gi = tid; gi < ng; gi += 512) {
            const int f = gi >> (logN - 2), bb = gi & ((N >> 2) - 1);
            const int j = bb & (q - 1), i = ((bb - j) << 2) + j;
            LAS f32x2* X = data + f * N;
            const f32x2 a0 = X[i], a1 = X[i + q], a2 = X[i + 2 * q], a3 = X[i + 3 * q];
            const f32x2 wa = tw1[j], wb = tw1[j + q], wc2 = tw2[j];
            const f32x2 s0 = a0 + a2, d0 = a0 - a2, s1 = a1 + a3, d1 = a1 - a3;
            f32x2 t0, t1; t0.x = d0.x * wa.x + d0.y * wa.y; t0.y = d0.y * wa.x - d0.x * wa.y; t1.x = d1.x * wb.x + d1.y * wb.y; t1.y = d1.y * wb.x - d1.x * wb.y;
            const f32x2 e0 = s0 - s1, e1 = t0 - t1;
            f32x2 r1, r3; r1.x = e0.x * wc2.x + e0.y * wc2.y; r1.y = e0.y * wc2.x - e0.x * wc2.y; r3.x = e1.x * wc2.x + e1.y * wc2.y; r3.y = e1.y * wc2.x - e1.x * wc2.y;
            X[i] = s0 + s1; X[i + q] = r1; X[i + 2 * q] = t0 + t1; X[i + 3 * q] = r3;
        }
        __syncthreads();
    }
    const float hs = isctx ? (0.5f / 128.f) : (0.5f / 512.f);
    bf16_t* AM = (bf16_t*)(p.ws + OFF_AM);
    const int g = quad >> 4, cc0 = 4 * (quad & 15);
#pragma unroll 1
    for (int i1 = tid; i1 < N; i1 += 512) {
        const int k = (int)(__brev((unsigned)i1) >> (32 - logN));
        const int k2 = (N - k) & (N - 1);
        const int i2 = (int)(__brev((unsigned)k2) >> (32 - logN));
        float re[4], im[4];
#pragma unroll
        for (int f = 0; f < 2; ++f) {
            const f32x2 X = data[f * N + i1], Y = data[f * N + i2];
            re[2 * f] = (X.x + Y.x) * hs; im[2 * f] = (X.y - Y.y) * hs; re[2 * f + 1] = (X.y + Y.y) * hs; im[2 * f + 1] = (Y.x - X.x) * hs;
        }
        bf16_t* dst = AM + (size_t)(rowbase + k) * 1280 + 768 + g * 128 + cc0;
        u32x2 o; o.x = pk2(re[0], re[1]); o.y = pk2(re[2], re[3]);
        *(u32x2*)dst = o;
        o.x = pk2(im[0], im[1]); o.y = pk2(im[2], im[3]);
        *(u32x2*)(dst + 64) = o;
    }
}

__device__ void pool_item(const Params& p, int item) {
    const int tid = otid();
    const int row = item * 16 + (tid >> 5), co = tid & 31, w = 2 << (co >> 3);
    int base, T;
    if (row < NL) { base = row & ~4095; T = 4096; } else { base = NL + ((row - NL) & ~255); T = 256; }
    const int tt = row - base;
    int lo = tt - (w >> 1), hi = lo + w; lo = lo < 0 ? 0 : lo; hi = hi > T ? T : hi;
    const bf16_t* U = (const bf16_t*)(p.ws + OFF_P1) + 768 + 8 * co;
    float s[8];
#pragma unroll
    for (int q = 0; q < 8; ++q) s[q] = 0.f;
    const int wlo = tt - (w >> 1);
    {
        GAS const bf16_t* Ug = (GAS const bf16_t*)(unsigned long long)U;
        u32x4 pv[16];
#pragma unroll
        for (int jj = 0; jj < 16; ++jj) { int j = wlo + jj; j = j < 0 ? 0 : (j >= T ? T - 1 : j); pv[jj] = *(GAS const u32x4*)(Ug + (size_t)(base + j) * P1LD); }
        asm volatile("" ::: "memory");
#pragma unroll
        for (int jj = 0; jj < 16; ++jj) {
            const int j = wlo + jj; const float mk = (jj < w && j >= 0 && j < T) ? 1.f : 0.f; const u32x4 v = pv[jj];
            s[0] += mk * bflo(v.x); s[1] += mk * bfhi(v.x); s[2] += mk * bflo(v.y); s[3] += mk * bfhi(v.y); s[4] += mk * bflo(v.z); s[5] += mk * bfhi(v.z); s[6] += mk * bflo(v.w); s[7] += mk * bfhi(v.w);
        }
    }
    const float ic = 1.f / (float)(hi - lo);
    const u32x4 v = *(const u32x4*)(U + (size_t)row * P1LD);
    u32x4 o; o.x = pk2(s[0] * ic - bflo(v.x), s[1] * ic - bfhi(v.x)); o.y = pk2(s[2] * ic - bflo(v.y), s[3] * ic - bfhi(v.y));
    o.z = pk2(s[4] * ic - bflo(v.z), s[5] * ic - bfhi(v.z)); o.w = pk2(s[6] * ic - bflo(v.w), s[7] * ic - bfhi(v.w));
    *(u32x4*)((bf16_t*)(p.ws + OFF_AM) + (size_t)row * 1280 + 512 + 8 * co) = o;
}

__device__ void phase_mix(const Params& p, int l, LAS unsigned char* lds) {
    const int n_attn = (l == 0) ? 544 : 512, n_fft = (l == 0) ? 512 : 256, n_pool = ((l == 0) ? NR : NL) / 16;
    const int total = n_attn + n_fft + n_pool;
    { const int tid = otid(); const f32x2* TW = (const f32x2*)(p.ws + OFF_TW); LAS f32x2* tw = (LAS f32x2*)(lds + 65536);
      for (int i = tid; i < 4095; i += 512) tw[i] = TW[i]; }
    for (int rep = 0; rep < ((PROBE & 7) && PROBE < 100 ? 2 : 1); ++rep)
    for (int it = blockIdx.x; it < total; it += gridDim.x) {
        if (it < n_attn) { if (rep == 0 || (PROBE & 1)) attn_item(p, l, it, lds); }
        else if (it < n_attn + n_fft) { const int j = it - n_attn; if (rep == 0 || (PROBE & 2)) { if (j < 256) fft_item(p, j, false, lds); else fft_item(p, j - 256, true, lds); } }
        else { if (rep == 0 || (PROBE & 4)) pool_item(p, it - n_attn - n_fft); }
    }
}

constexpr int N_PHASES = 18;
__global__ void __launch_bounds__(512) mega(Params pk) {
    extern __shared__ __attribute__((aligned(16))) unsigned char shm[];
    LAS unsigned char* lds = (LAS unsigned char*)shm;
    cg::grid_group grid = cg::this_grid();
    LAS Params* lp = (LAS Params*)(lds + PRM_OFF);
    if (threadIdx.x < 23) ((LAS unsigned long long*)lp)[threadIdx.x] = ((const unsigned long long*)&pk)[threadIdx.x];
    if (threadIdx.x < 4) ((LAS unsigned*)(lds + PRM_OFF + 512))[threadIdx.x] = 0u;
    __syncthreads();
    const XcdBarrier xb = xcd_barrier_post((unsigned*)(pk.ws + OFF_BAR), (volatile LAS unsigned*)(lds + PRM_OFF + 512));
    const int ph_lo = __builtin_amdgcn_readfirstlane(lp->ph_lo), ph_hi = __builtin_amdgcn_readfirstlane(lp->ph_hi);
    for (int ph = ph_lo; ph < ph_hi; ++ph) {
        const int l = (ph - 1) / 8, sub = (ph == 0) ? 9 : (((ph - 1) % 8) == 7 ? 8 : (ph - 1) % 8);
        int nrep = 1;
#if PROBE >= 100
        if (ph < N_PHASES - 1 && sub == (PROBE % 100)) nrep = 2;
#endif
        for (int rep = 0; rep < nrep; ++rep) {
            const bool dry = (PROBE >= 200) && (rep == 0) && (nrep == 2);
            if (ph == 0) { const Params p = load_params(lp); phase_prep(p, lds); }
            else if (ph == N_PHASES - 1) { const Params p = load_params(lp); phase_final(p); }
            else if (sub == 0 || sub == 5) { const Params p = load_params(lp); phase_norm(p, l, sub == 5); }
            else if (sub == 2) { const Params p = load_params(lp); phase_mix(p, l, lds); }
            else { for (int gi = 0; gi < 6; ++gi) { if (!gemm_phase(lds, l, sub, gi, dry)) break; } }
            if (rep + 1 < nrep) xcd_barrier(xb);
        }
        if (ph + 1 < ph_hi) xcd_barrier(xb);
        if (ph_hi > 1000) grid.sync();
    }
}

extern "C" void kernel_launch(void* const* d_in, const int* in_sizes, int n_in, void* d_out, int out_size, void* d_ws, size_t ws_size, hipStream_t stream) {
    static int grid_blocks = 0;
    if (!grid_blocks) {
        int dev = 0, cus = 0, per_cu = 0;
        hipGetDevice(&dev);
        hipDeviceGetAttribute(&cus, hipDeviceAttributeMultiprocessorCount, dev);
        hipFuncSetAttribute((const void*)mega, hipFuncAttributeMaxDynamicSharedMemorySize, LDS_BYTES);
        if (hipOccupancyMaxActiveBlocksPerMultiprocessor(&per_cu, (const void*)mega, 512, LDS_BYTES) != hipSuccess || per_cu < 1) per_cu = 1;
        (void)hipGetLastError();
        if (per_cu > 1) per_cu = 1;
        grid_blocks = cus * per_cu;
        if (ws_size < 256 * MiB) fprintf(stderr, "kernel_launch: workspace too small (%zu)\n", ws_size);
    }
    Params p{};
    const float** pp = (const float**)&p;
    for (int i = 0; i < 20; ++i) pp[i] = (const float*)d_in[i];
    p.out = (float*)d_out; p.ws = (unsigned char*)d_ws; p.ph_lo = 0; p.ph_hi = N_PHASES;
    (void)hipMemsetAsync((char*)d_ws + OFF_BAR, 0, XCD_BAR_WORDS * 4, stream);
    void* args[] = {&p};
    hipError_t e = hipLaunchCooperativeKernel((const void*)mega, dim3(grid_blocks), dim3(512), args, LDS_BYTES, stream);
    if (e != hipSuccess) fprintf(stderr, "cooperative launch failed: %s (grid %d)\n", hipGetErrorString(e), grid_blocks);
}
```

```cpp
#include <hip/hip_runtime.h>
#include <hip/hip_cooperative_groups.h>
#include <cstdio>
namespace cg = cooperative_groups;
#ifndef PROBE
#define PROBE 0
#endif

#define LAS __attribute__((address_space(3)))
typedef unsigned short bf16_t;
typedef short bf16x8 __attribute__((ext_vector_type(8)));
typedef float f32x2 __attribute__((ext_vector_type(2)));
typedef float f32x4 __attribute__((ext_vector_type(4)));
typedef float f32x16 __attribute__((ext_vector_type(16)));
typedef unsigned u32x2 __attribute__((ext_vector_type(2)));
typedef unsigned u32x4 __attribute__((ext_vector_type(4)));

constexpr int NL = 16384, NCX = 1024, NR = NL + NCX, DM = 1024;
constexpr int INW = 4352, DFF = 2816, DFH = 1408;
constexpr int P1LD = 1280;
constexpr int LDS_BYTES = 147456 + 1024, PRM_OFF = 147456;
constexpr float LOG2E = 1.4426950408889634f;

constexpr size_t MiB = 1048576;
constexpr size_t OFF_MOD = 0;
constexpr size_t OFF_ROPE = 262144;
constexpr size_t OFF_TW = 262144 + 16384;
constexpr size_t OFF_BAR = 1 * MiB;
constexpr size_t OFF_XC = 2 * MiB;
constexpr size_t OFF_W = 6 * MiB;
constexpr size_t LW_WIN = 0, LW_WM = (size_t)INW * 1024 * 2, LW_WO = LW_WM + (size_t)1024 * 1280 * 2, LW_WUP = LW_WO + (size_t)1024 * 1024 * 2,
                 LW_WD = LW_WUP + (size_t)5632 * 1024 * 2, LW = LW_WD + (size_t)1024 * DFF * 2;
constexpr size_t OFF_H = 65 * MiB;
constexpr size_t OFF_R = 99 * MiB;
constexpr size_t OFF_P1 = OFF_R;
constexpr size_t OFF_AM = OFF_R + 85 * MiB / 2;
constexpr size_t OFF_YM = OFF_AM + 85 * MiB / 2;
constexpr size_t OFF_ACT = OFF_R;
constexpr size_t OFF_HB = OFF_R + 94 * MiB;
constexpr size_t OFF_PART = 198 * MiB;
constexpr size_t OFF_GC = 218 * MiB;
static_assert(OFF_W + 2 * LW == OFF_H, "weights region");
static_assert(OFF_YM + 34 * MiB <= 256 * MiB && OFF_ACT + (size_t)NR * DFF * 2 <= OFF_HB && OFF_HB + 4 * MiB <= 256 * MiB, "ws");

struct Params {
    const float *x, *c, *ctx, *c_ctx, *w_mod, *b_mod, *norm_mix, *norm_ffn, *w_in, *attn_sink, *pool_w, *pool_scale,
        *w_br_attn, *w_br_pool, *w_br_four, *w_out, *w_up, *conv_w, *w_down, *norm_final;
    float* out; unsigned char* ws; int ph_lo, ph_hi;
};

__device__ __forceinline__ unsigned pk2(float lo, float hi) { unsigned r; asm volatile("v_cvt_pk_bf16_f32 %0, %1, %2" : "=v"(r) : "v"(lo), "v"(hi)); return r; }
__device__ __forceinline__ float bflo(unsigned w) { return __uint_as_float(w << 16); }
__device__ __forceinline__ float bfhi(unsigned w) { return __uint_as_float(w & 0xffff0000u); }
__device__ __forceinline__ float wave_sum(float v) {
#pragma unroll
    for (int o = 1; o < 64; o <<= 1) v += __shfl_xor(v, o);
    return v;
}
__device__ __forceinline__ Params load_params(LAS const Params* lp) { Params p;
#pragma unroll
    for (int i = 0; i < 23; ++i) ((unsigned long long*)&p)[i] = ((LAS const unsigned long long*)lp)[i];
    return p; }
__device__ __forceinline__ int otid() { int t = threadIdx.x; asm volatile("" : "+v"(t)); return t; }
template <class T> __device__ __forceinline__ T* uptr(T* q) { const unsigned long long v = (unsigned long long)q; const unsigned lo = __builtin_amdgcn_readfirstlane((unsigned)v), hi = __builtin_amdgcn_readfirstlane((unsigned)(v >> 32)); return (T*)(((unsigned long long)hi << 32) | lo); }
__device__ __forceinline__ float fast_sigmoid(float x) { return __builtin_amdgcn_rcpf(1.0f + __builtin_amdgcn_exp2f(-x * LOG2E)); }


#define XB_TMO      128
#define XB_XCNT(j)  (256  + 64 * (j))
#define XB_XSUB(j)  (1280 + 64 * (j))
#define XB_XGEN(j)  (2304 + 64 * (j))
#define XB_TOP      3328
#define XB_TOPGEN   3392
#define XCD_BAR_WORDS 3456
#define XB_SPIN_CAP (1u << 18)
__device__ __forceinline__ unsigned xb_ld(unsigned* p)              { return __hip_atomic_load(p, __ATOMIC_RELAXED, __HIP_MEMORY_SCOPE_AGENT); }
__device__ __forceinline__ unsigned xb_add(unsigned* p, unsigned v) { return __hip_atomic_fetch_add(p, v, __ATOMIC_RELAXED, __HIP_MEMORY_SCOPE_AGENT); }
__device__ __forceinline__ unsigned xb_xcc_id() { return (unsigned)__builtin_amdgcn_s_getreg((3 << 11) | 20) & 0xFu; }
#define XB_SPIN(cond, bar) do { unsigned _sp = 0; while (cond) { __builtin_amdgcn_s_sleep(1); \
    if ((++_sp & 255u) == 0u) { if (xb_ld(&(bar)[XB_TMO])) break; if (_sp > XB_SPIN_CAP) { atomicAdd(&(bar)[XB_TMO], 1u); break; } } } } while (0)
struct XcdBarrier { unsigned* bar; unsigned x; volatile LAS unsigned* st; };
__device__ __forceinline__ XcdBarrier xcd_barrier_post(unsigned* bar, volatile LAS unsigned* st) {
    XcdBarrier b; b.bar = bar; b.x = xb_xcc_id(); b.st = st;
    if (threadIdx.x == 0) (void)xb_add(&bar[XB_XCNT(b.x)], 1u);
    return b;
}
__device__ __forceinline__ void xcd_barrier_complete(unsigned* bar, unsigned x, unsigned& nloc, unsigned& nx) {
    const unsigned G = gridDim.x * gridDim.y * gridDim.z;
    unsigned sum, cnt, mine, sp = 0u;
    for (;;) {
        sum = 0u; cnt = 0u; mine = 0u;
#pragma unroll
        for (unsigned j = 0; j < 16; ++j) { const unsigned c = xb_ld(&bar[XB_XCNT(j)]); sum += c; cnt += (c > 0u) ? 1u : 0u; mine = (j == x) ? c : mine; }
        if (sum == G) break;
        __builtin_amdgcn_s_sleep(1);
        if ((++sp & 255u) == 0u) { if (xb_ld(&bar[XB_TMO])) break; if (sp > XB_SPIN_CAP) { atomicAdd(&bar[XB_TMO], 1u); break; } }
    }
    nloc = mine > 0u ? mine : 1u; nx = cnt > 0u ? cnt : 1u;
}
__device__ __forceinline__ void xcd_barrier(const XcdBarrier& b) {
    asm volatile("s_waitcnt vmcnt(0)" ::: "memory");
    __syncthreads();
    if (threadIdx.x == 0) {
        unsigned* bar = b.bar;
        __builtin_amdgcn_s_waitcnt(0);
        unsigned nloc = b.st[0], nx = b.st[1];
        if (nloc == 0u) { xcd_barrier_complete(bar, b.x, nloc, nx); b.st[0] = nloc; b.st[1] = nx; }
        const unsigned old = xb_add(&bar[XB_XSUB(b.x)], 1u);
        const unsigned gen = old / nloc;
        if (old + 1u == (gen + 1u) * nloc) {
            __builtin_amdgcn_fence(__ATOMIC_RELEASE, "agent");
            asm volatile("s_waitcnt vmcnt(0)" ::: "memory");
            const unsigned og = xb_add(&bar[XB_TOP], 1u);
            const unsigned tg = og / nx;
            if (og + 1u == (tg + 1u) * nx) xb_add(&bar[XB_TOPGEN], 1u);
            else XB_SPIN(xb_ld(&bar[XB_TOPGEN]) == tg, bar);
            __builtin_amdgcn_fence(__ATOMIC_ACQUIRE, "agent");
            xb_add(&bar[XB_XGEN(b.x)], 1u);
            asm volatile("s_waitcnt vmcnt(0)" ::: "memory");
        } else {
            XB_SPIN(xb_ld(&bar[XB_XGEN(b.x)]) == gen, bar);
            __builtin_amdgcn_fence(__ATOMIC_ACQUIRE, "agent");
            asm volatile("s_waitcnt vmcnt(0)" ::: "memory");
        }
    }
    __syncthreads();
}

constexpr int BM = 256, BK = 64, HALF = 128, HTB = HALF * BK * 2, NXCD = 8, WGM = 4;
__device__ __forceinline__ int lds_byte(int r, int c) { const int st = (r >> 4) * 2 + (c >> 5), rr = r & 15, cc = c & 31, ob = rr * 64 + cc * 2; return st * 1024 + (ob ^ (((ob >> 9) & 1) << 5)); }
__device__ __forceinline__ void stage_rc(int b, int& R, int& C) { const int st = b / 1024, sb = b % 1024, swz = sb ^ (((sb >> 9) & 1) << 5); R = (st >> 1) * 16 + swz / 64; C = (st & 1) * 32 + (swz % 64) / 2; }
__device__ __forceinline__ int perm32(int rho) { const int n = rho >> 4, i = rho & 15; return 8 * (i >> 2) + 4 * n + (i & 3); }

enum { M_P1 = 0, M_BF16 = 1, M_GATE = 2, M_YSET = 3, M_YADD = 4, M_RES = 5, M_UPC = 6 };
struct GD {
    const bf16_t* A; const bf16_t* Bt; int lda, ldb, K, nM, nN, row0, mode, splitk;
    bf16_t* out; int ldc; const bf16_t* aux;
    const float* gm; const float* xin_lat; const float* xin_ctx; float* xout_lat; float* xout_ctx;
    const float* rope; const float* cw;
    int sctx, xctx; bf16_t* auxc;
};
struct Unit { int pm, pn, k0; };
constexpr int SK_S = 11, SK_NT = 4;
__device__ __forceinline__ bool unit_next(const GD& g, int i, Unit& u) {
    int nM = g.nM; const int nN = g.nN;
    const long L = (long)i * gridDim.x + blockIdx.x;
    u.k0 = 0;
    if (g.splitk) {
        if (L >= 16 * SK_S) return false;
        const int tile = (int)(L / SK_S), ks = (int)(L % SK_S); u.pm = 64 + (tile >> 2); u.pn = tile & 3; u.k0 = ks * SK_NT; return true;
    }
    if (g.sctx) {
        nM = 64;
        const long nb = (long)nM * nN;
        if (L >= nb) { const int sidx = (int)(L - nb), wN = nN + g.xctx; if (sidx >= 4 * wN) return false; u.pm = 64 + sidx / wN; u.pn = sidx % wN; return true; }
    }
    const int nwg = nM * nN;
    if (L >= nwg) return false;
    int wgid = (int)L; { const int q = nwg / NXCD, r = nwg % NXCD, xcd = wgid % NXCD, off = wgid / NXCD; wgid = (xcd < r ? xcd * (q + 1) : r * (q + 1) + (xcd - r) * q) + off; }
    const int nig = WGM * nN, gid = wgid / nig, fm = gid * WGM, gsz = (nM - fm) < WGM ? (nM - fm) : WGM;
    u.pm = fm + ((wgid % nig) % gsz); u.pn = (wgid % nig) / gsz; return true;
}

#ifndef MB
#define MB 1
#endif
#ifndef MBR
#define MBR 4
#endif
#ifndef MBG
#define MBG 2
#endif
#define GAS __attribute__((address_space(1)))
__device__ __forceinline__ unsigned char* lds_params_ws(LAS unsigned char* lds) { return ((LAS const Params*)(lds + PRM_OFF))->ws; }
template <class T> __device__ __forceinline__ GAS T* gptr(T* q) { return (GAS T*)(unsigned long long)uptr(q); }
__device__ __forceinline__ void gemm_epilogue(LAS unsigned char* lds, const GD& gd, const f32x4 (&acc)[2][2][4][2], const Unit& u) {
    const int tid_e = otid(), wid_e = __builtin_amdgcn_readfirstlane(tid_e >> 6), wr = wid_e >> 2, wc = wid_e & 3, fr = tid_e & 15, fq = (tid_e >> 4) & 3;
    const int mode = __builtin_amdgcn_readfirstlane(gd.mode);
    const int row_u = __builtin_amdgcn_readfirstlane(gd.row0) + u.pm * BM;
    const int lrow = wr * 64 + fr;
    if (mode == M_UPC) {
        const int chl = wc * 32 + 8 * fq;
        GAS const float* cwu = gptr(gd.cw + u.pn * 128);
        f32x4 cwv[2][3], cwg[2][3];
#pragma unroll
        for (int n = 0; n < 2; ++n)
#pragma unroll
            for (int tp = 0; tp < 3; ++tp) { cwv[n][tp] = *(GAS const f32x4*)(cwu + tp * 5632 + chl + 4 * n); cwg[n][tp] = *(GAS const f32x4*)(cwu + tp * 5632 + DFF + chl + 4 * n); }
        asm volatile("" ::: "memory");
        LAS float* EX = (LAS float*)(lds + 131072);
#define EXI(ai_, wr_, tb_) ((((((ai_) * 2 + (wr_)) * 4 + wc) * 2 + (tb_)) * 4 + fq) * 16)
#pragma unroll
        for (int ai = 0; ai < 2; ++ai)
#pragma unroll
            for (int bj = 0; bj < 2; ++bj)
#pragma unroll
                for (int n = 0; n < 2; ++n) {
                    if (fr == 0) *(LAS f32x4*)(EX + EXI(ai, wr, 0) + bj * 8 + n * 4) = acc[ai][bj][0][n];
                    if (fr == 15) *(LAS f32x4*)(EX + EXI(ai, wr, 1) + bj * 8 + n * 4) = acc[ai][bj][3][n];
                }
        {
            GAS bf16_t* HB = gptr((bf16_t*)gd.aux + (size_t)u.pm * 4 * 5632 + u.pn * 256) + wc * 32 + 8 * fq;
            if (wr == 0 && fr == 0) {
#pragma unroll
                for (int mm = 0; mm < 2; ++mm)
#pragma unroll
                    for (int bj = 0; bj < 2; ++bj) { const f32x4 v0 = acc[0][bj][mm][0], v1 = acc[0][bj][mm][1];
                        u32x4 w; w.x = pk2(v0[0], v0[1]); w.y = pk2(v0[2], v0[3]); w.z = pk2(v1[0], v1[1]); w.w = pk2(v1[2], v1[3]);
                        *(GAS u32x4*)(HB + mm * 5632 + bj * HALF) = w; }
            }
            if (wr == 1 && fr == 15) {
#pragma unroll
                for (int mm = 2; mm < 4; ++mm)
#pragma unroll
                    for (int bj = 0; bj < 2; ++bj) { const f32x4 v0 = acc[1][bj][mm][0], v1 = acc[1][bj][mm][1];
                        u32x4 w; w.x = pk2(v0[0], v0[1]); w.y = pk2(v0[2], v0[3]); w.z = pk2(v1[0], v1[1]); w.w = pk2(v1[2], v1[3]);
                        *(GAS u32x4*)(HB + mm * 5632 + bj * HALF) = w; }
            }
        }
        asm volatile("s_waitcnt lgkmcnt(0)" ::: "memory");
        __builtin_amdgcn_s_barrier();
        __builtin_amdgcn_s_barrier();
        asm volatile("" ::: "memory");
        GAS bf16_t* outu = gptr(gd.out + (size_t)row_u * DFF + u.pn * 128);
        const unsigned ooff = (unsigned)((wr * 64 + 4 * fr) * DFF + chl);
#pragma unroll
        for (int ai = 0; ai < 2; ++ai) {
            const bool has_prev = !(ai == 0 && wr == 0), has_next = !(ai == 1 && wr == 1);
            const int pa = wr ? ai : ai - 1, pw = wr ? 0 : 1, na = wr ? ai + 1 : ai, nw = wr ? 0 : 1;
            unsigned actw[4][4];
#pragma unroll
            for (int n = 0; n < 2; ++n) {
                f32x4 ep[2], en[2];
#pragma unroll
                for (int bj = 0; bj < 2; ++bj) {
                    ep[bj] = has_prev ? *(const LAS f32x4*)(EX + EXI(pa, pw, 1) + bj * 8 + n * 4) : (f32x4){0.f, 0.f, 0.f, 0.f};
                    en[bj] = has_next ? *(const LAS f32x4*)(EX + EXI(na, nw, 0) + bj * 8 + n * 4) : (f32x4){0.f, 0.f, 0.f, 0.f};
                }
#pragma unroll
                for (int jp = 0; jp < 2; ++jp) {
                    f32x2 cv[2][4];
#pragma unroll
                    for (int bj = 0; bj < 2; ++bj) {
                        const f32x4 W0 = bj ? cwg[n][0] : cwv[n][0], W1 = bj ? cwg[n][1] : cwv[n][1], W2 = bj ? cwg[n][2] : cwv[n][2];
                        f32x2 w0, w1, w2;
                        w0.x = W0[2 * jp]; w0.y = W0[2 * jp + 1]; w1.x = W1[2 * jp]; w1.y = W1[2 * jp + 1]; w2.x = W2[2 * jp]; w2.y = W2[2 * jp + 1];
                        f32x2 cur[4];
#pragma unroll
                        for (int m = 0; m < 4; ++m) { cur[m].x = acc[ai][bj][m][n][2 * jp]; cur[m].y = acc[ai][bj][m][n][2 * jp + 1]; }
                        float pvx = __builtin_bit_cast(float, __builtin_amdgcn_update_dpp(0, __builtin_bit_cast(int, (float)cur[3].x), 0x121, 0xF, 0xF, false));
                        float pvy = __builtin_bit_cast(float, __builtin_amdgcn_update_dpp(0, __builtin_bit_cast(int, (float)cur[3].y), 0x121, 0xF, 0xF, false));
                        float nxx = __builtin_bit_cast(float, __builtin_amdgcn_update_dpp(0, __builtin_bit_cast(int, (float)cur[0].x), 0x12F, 0xF, 0xF, false));
                        float nxy = __builtin_bit_cast(float, __builtin_amdgcn_update_dpp(0, __builtin_bit_cast(int, (float)cur[0].y), 0x12F, 0xF, 0xF, false));
                        pvx = (fr == 0) ? ep[bj][2 * jp] : pvx; pvy = (fr == 0) ? ep[bj][2 * jp + 1] : pvy;
                        nxx = (fr == 15) ? en[bj][2 * jp] : nxx; nxy = (fr == 15) ? en[bj][2 * jp + 1] : nxy;
                        f32x2 above, below; above.x = pvx; above.y = pvy; below.x = nxx; below.y = nxy;
#pragma unroll
                        for (int m = 0; m < 4; ++m) {
                            const f32x2 pv = (m == 0) ? above : cur[m > 0 ? m - 1 : 0];
                            const f32x2 nx = (m == 3) ? below : cur[m < 3 ? m + 1 : 3];
                            cv[bj][m] = w0 * pv + w1 * cur[m] + w2 * nx;
                        }
                    }
#pragma unroll
                    for (int m = 0; m < 4; ++m) {
                        const f32x2 gq = cv[1][m];
                        f32x2 sg; sg.x = fast_sigmoid(gq.x); sg.y = fast_sigmoid(gq.y);
                        const f32x2 a2 = cv[0][m] * gq * sg;
                        actw[m][2 * n + jp] = pk2(a2.x, a2.y);
                    }
                }
            }
#pragma unroll
            for (int m = 0; m < 4; ++m) {
                u32x4 o; o.x = actw[m][0]; o.y = actw[m][1]; o.z = actw[m][2]; o.w = actw[m][3];
                *(GAS u32x4*)(outu + ooff + (ai * HALF + m) * DFF) = o;
            }
        }
#undef EXI
        return;
    }
    if (mode == M_RES) {
        const bool lat = row_u < NL;
        const int rb = lat ? (row_u >> 12) : 4;
        GAS const float* gmr = gptr(gd.gm + rb * 6144 + u.pn * BM);
        GAS const float* xin = gptr((lat ? gd.xin_lat : gd.xin_ctx - (size_t)NL * DM) + (size_t)row_u * DM + u.pn * BM);
        GAS float* xout = gptr((lat ? gd.xout_lat : gd.xout_ctx - (size_t)NL * DM) + (size_t)row_u * DM + u.pn * BM);
        const int lcol = wc * 32 + 4 * fq;
        const unsigned xoff = (unsigned)(lrow * DM + lcol);
        f32x4 gv[2][2];
#pragma unroll
        for (int bj = 0; bj < 2; ++bj)
#pragma unroll
            for (int n = 0; n < 2; ++n) gv[bj][n] = *(GAS const f32x4*)(gmr + lcol + bj * HALF + n * 16);
        if (gd.splitk) {
            GAS float* part = gptr((float*)(lds_params_ws(lds) + OFF_PART) + ((size_t)(u.k0 / SK_NT) * 1024 + (row_u - NL)) * DM + u.pn * BM);
#pragma unroll
            for (int ai = 0; ai < 2; ++ai)
#pragma unroll
                for (int m = 0; m < 4; ++m)
#pragma unroll
                    for (int bj = 0; bj < 2; ++bj)
#pragma unroll
                        for (int n = 0; n < 2; ++n) *(GAS f32x4*)(part + xoff + (ai * HALF + m * 16) * DM + bj * HALF + n * 16) = gv[bj][n] * acc[ai][bj][m][n];
            return;
        }
#pragma unroll
        for (int am = 0; am < 8 / MBR; ++am) {
            const int ai = (am * MBR) >> 2, m0 = (am * MBR) & 3;
            f32x4 xi[MBR][2][2];
#pragma unroll
            for (int mm = 0; mm < MBR; ++mm)
#pragma unroll
                for (int bj = 0; bj < 2; ++bj)
#pragma unroll
                    for (int n = 0; n < 2; ++n) xi[mm][bj][n] = *(GAS const f32x4*)(xin + xoff + (ai * HALF + (m0 + mm) * 16) * DM + bj * HALF + n * 16);
            asm volatile("" ::: "memory");
#pragma unroll
            for (int mm = 0; mm < MBR; ++mm)
#pragma unroll
                for (int bj = 0; bj < 2; ++bj)
#pragma unroll
                    for (int n = 0; n < 2; ++n) *(GAS f32x4*)(xout + xoff + (ai * HALF + (m0 + mm) * 16) * DM + bj * HALF + n * 16) = xi[mm][bj][n] + gv[bj][n] * acc[ai][bj][m0 + mm][n];
        }
        return;
    }
    int ldc = __builtin_amdgcn_readfirstlane(gd.ldc);
    const int lcol = wc * 32 + 8 * fq;
    const bool ctx_gate_out = (mode == M_P1) && (u.pn >= 5);
    const bool ctx_gate_in = (row_u >= NL) && (gd.auxc != nullptr);
    const int emode = ctx_gate_out ? (int)M_GATE : mode;
    if (ctx_gate_out) ldc = 3072;
    const int apitch = ctx_gate_in ? 3072 : 1024;
    GAS bf16_t* outu = gptr(ctx_gate_out ? gd.auxc + (size_t)(row_u - NL) * 3072 + (u.pn - 5) * BM : gd.out + (size_t)row_u * ldc + u.pn * BM);
    GAS const bf16_t* auxu = gptr(ctx_gate_in ? (const bf16_t*)gd.auxc + (size_t)(row_u - NL) * 3072 + u.pn * BM : gd.aux + (size_t)row_u * 1024 + u.pn * BM);
    const unsigned ooff = (unsigned)(lrow * ldc + lcol), goff = (unsigned)(lrow * apitch + lcol);
    if (mode == M_YSET || mode == M_YADD) {
#pragma unroll
        for (int am = 0; am < 8 / MBG; ++am) {
            const int ai = (am * MBG) >> 2, m0 = (am * MBG) & 3;
            u32x4 gw[MBG][2], yw[MBG][2];
#pragma unroll
            for (int mm = 0; mm < MBG; ++mm)
#pragma unroll
                for (int bj = 0; bj < 2; ++bj) {
                    const int ro = ai * HALF + (m0 + mm) * 16;
                    gw[mm][bj] = *(GAS const u32x4*)(auxu + goff + ro * apitch + bj * HALF);
                    if (mode == M_YADD) yw[mm][bj] = *(GAS const u32x4*)(outu + ooff + ro * ldc + bj * HALF);
                }
            asm volatile("" ::: "memory");
#pragma unroll
            for (int mm = 0; mm < MBG; ++mm) {
                const int m = m0 + mm;
#pragma unroll
                for (int bj = 0; bj < 2; ++bj) {
                    f32x4 v0 = acc[ai][bj][m][0], v1 = acc[ai][bj][m][1];
                    const u32x4 q = gw[mm][bj];
                    v0[0] *= bflo(q.x); v0[1] *= bfhi(q.x); v0[2] *= bflo(q.y); v0[3] *= bfhi(q.y);
                    v1[0] *= bflo(q.z); v1[1] *= bfhi(q.z); v1[2] *= bflo(q.w); v1[3] *= bfhi(q.w);
                    if (mode == M_YADD) {
                        const u32x4 y = yw[mm][bj];
                        v0[0] += bflo(y.x); v0[1] += bfhi(y.x); v0[2] += bflo(y.y); v0[3] += bfhi(y.y);
                        v1[0] += bflo(y.z); v1[1] += bfhi(y.z); v1[2] += bflo(y.w); v1[3] += bfhi(y.w);
                    }
                    u32x4 w; w.x = pk2(v0[0], v0[1]); w.y = pk2(v0[2], v0[3]); w.z = pk2(v1[0], v1[1]); w.w = pk2(v1[2], v1[3]);
                    *(GAS u32x4*)(outu + ooff + (ai * HALF + m * 16) * ldc + bj * HALF) = w;
                }
            }
        }
        return;
    }
    const bool rope_unit = (mode == M_P1) && (row_u < NL) && (u.pn <= 2);
#pragma unroll
    for (int am = 0; am < 8; ++am) {
        const int ai = am >> 2, m = am & 3;
        f32x4 cs[4];
        if (rope_unit) {
            const int row = row_u + lrow + ai * HALF + m * 16;
            const int t = row & 4095, pos = (wc & 1) ? (t & 63) : (t >> 6);
            const LAS f32x4* cp = (const LAS f32x4*)(lds + 139264 + (pos * 16 + 8 * (fq & 1)) * 8);
#pragma unroll
            for (int q = 0; q < 4; ++q) cs[q] = cp[q];
        }
#pragma unroll
        for (int bj = 0; bj < 2; ++bj) {
            f32x4 v0 = acc[ai][bj][m][0], v1 = acc[ai][bj][m][1];
            if (rope_unit && !(u.pn == 0 && bj == 1)) {
                const float sg = (fq < 2) ? -1.f : 1.f;
#pragma unroll
                for (int j = 0; j < 4; ++j) {
                    const float p0 = __shfl_xor(v0[j], 32), p1 = __shfl_xor(v1[j], 32);
                    const float c0 = cs[j >> 1][(j & 1) * 2], s0 = cs[j >> 1][(j & 1) * 2 + 1];
                    const float c1 = cs[2 + (j >> 1)][(j & 1) * 2], s1 = cs[2 + (j >> 1)][(j & 1) * 2 + 1];
                    v0[j] = v0[j] * c0 + sg * p0 * s0; v1[j] = v1[j] * c1 + sg * p1 * s1;
                }
            }
            if (emode == M_GATE) {
#pragma unroll
                for (int j = 0; j < 4; ++j) { v0[j] = fast_sigmoid(v0[j]); v1[j] = fast_sigmoid(v1[j]); }
            }
            u32x4 w; w.x = pk2(v0[0], v0[1]); w.y = pk2(v0[2], v0[3]); w.z = pk2(v1[0], v1[1]); w.w = pk2(v1[2], v1[3]);
            *(GAS u32x4*)(outu + ooff + (ai * HALF + m * 16) * ldc + bj * HALF) = w;
        }
    }
}

__device__ __forceinline__ void fixup_tile(const bf16_t* HBp, bf16_t* ACTp, const float* cwp, int pm) {
    const int tid = otid();
    if (pm >= 64 || tid >= 352) return;
    GAS const bf16_t* HB = (GAS const bf16_t*)(unsigned long long)HBp;
    GAS bf16_t* ACT = (GAS bf16_t*)(unsigned long long)ACTp;
    GAS const float* cw = (GAS const float*)(unsigned long long)cwp;
    const int ch = tid * 8, col = 256 * (ch >> 7) + (ch & 127);
    const bool up_nb = (pm & 15) != 0, dn_nb = (pm & 15) != 15;
    const u32x4 z = {0u, 0u, 0u, 0u};
    GAS const bf16_t* h0 = HB + (size_t)pm * 4 * 5632 + col;
    u32x4 rv[6], rg[6];
    rv[0] = up_nb ? *(GAS const u32x4*)(h0 - 5632) : z;          rg[0] = up_nb ? *(GAS const u32x4*)(h0 - 5632 + 128) : z;
    rv[1] = *(GAS const u32x4*)(h0);                              rg[1] = *(GAS const u32x4*)(h0 + 128);
    rv[2] = *(GAS const u32x4*)(h0 + 5632);                       rg[2] = *(GAS const u32x4*)(h0 + 5632 + 128);
    rv[3] = *(GAS const u32x4*)(h0 + 2 * 5632);                   rg[3] = *(GAS const u32x4*)(h0 + 2 * 5632 + 128);
    rv[4] = *(GAS const u32x4*)(h0 + 3 * 5632);                   rg[4] = *(GAS const u32x4*)(h0 + 3 * 5632 + 128);
    rv[5] = dn_nb ? *(GAS const u32x4*)(h0 + 4 * 5632) : z;      rg[5] = dn_nb ? *(GAS const u32x4*)(h0 + 4 * 5632 + 128) : z;
    float wv[3][8], wg[3][8];
#pragma unroll
    for (int t = 0; t < 3; ++t) {
        const f32x4 a0 = *(GAS const f32x4*)(cw + t * 5632 + ch), a1 = *(GAS const f32x4*)(cw + t * 5632 + ch + 4);
        const f32x4 b0 = *(GAS const f32x4*)(cw + t * 5632 + DFF + ch), b1 = *(GAS const f32x4*)(cw + t * 5632 + DFF + ch + 4);
#pragma unroll
        for (int q = 0; q < 4; ++q) { wv[t][q] = a0[q]; wv[t][4 + q] = a1[q]; wg[t][q] = b0[q]; wg[t][4 + q] = b1[q]; }
    }
    asm volatile("" ::: "memory");
#pragma unroll
    for (int r = 0; r < 2; ++r) {
        if (r == 0 ? !up_nb : !dn_nb) continue;
        float a[8];
#pragma unroll
        for (int q = 0; q < 8; ++q) {
            const int w = q >> 1;
            float v[3], gq[3];
#pragma unroll
            for (int t = 0; t < 3; ++t) {
                const unsigned uv = rv[3 * r + t][w], ug = rg[3 * r + t][w];
                v[t] = (q & 1) ? bfhi(uv) : bflo(uv); gq[t] = (q & 1) ? bfhi(ug) : bflo(ug);
            }
            const float cvv = wv[0][q] * v[0] + wv[1][q] * v[1] + wv[2][q] * v[2];
            const float cg = wg[0][q] * gq[0] + wg[1][q] * gq[1] + wg[2][q] * gq[2];
            a[q] = cvv * cg * fast_sigmoid(cg);
        }
        u32x4 o; o.x = pk2(a[0], a[1]); o.y = pk2(a[2], a[3]); o.z = pk2(a[4], a[5]); o.w = pk2(a[6], a[7]);
        *(GAS u32x4*)(ACT + (size_t)(256 * pm + (r ? 255 : 0)) * DFF + ch) = o;
    }
}

__device__ __forceinline__ bool make_gd(LAS const Params* lp, int l, int sub, int gi, GD& g) {
    Params p; p.ws = lp->ws; p.out = lp->out; p.x = lp->x; p.ctx = lp->ctx;
    unsigned char* ws = p.ws;
    const unsigned char* wb = ws + OFF_W + (size_t)l * LW;
    const bf16_t* WinT = (const bf16_t*)(wb + LW_WIN); const bf16_t* WmT = (const bf16_t*)(wb + LW_WM); const bf16_t* WoT = (const bf16_t*)(wb + LW_WO);
    const bf16_t* WupT = (const bf16_t*)(wb + LW_WUP); const bf16_t* WdT = (const bf16_t*)(wb + LW_WD);
    const bf16_t* H = (const bf16_t*)(ws + OFF_H);
    bf16_t* P1 = (bf16_t*)(ws + OFF_P1); bf16_t* AM = (bf16_t*)(ws + OFF_AM); bf16_t* YM = (bf16_t*)(ws + OFF_YM);
    const float* mod = (const float*)(ws + OFF_MOD) + (size_t)l * 5 * 6144;
    const int mt = (l == 0) ? 68 : 64;
    g.row0 = 0; g.splitk = 0; g.sctx = 0; g.xctx = 0; g.auxc = nullptr; g.aux = P1; g.gm = mod; g.rope = (const float*)(ws + OFF_ROPE);
    g.xin_lat = p.out; g.xin_ctx = (const float*)(ws + OFF_XC); g.xout_lat = p.out; g.xout_ctx = (float*)(ws + OFF_XC);
    g.out = P1; g.ldc = 1024; g.lda = 1024; g.ldb = 1024; g.K = 1024;
    switch (sub) {
    case 1:
        if (gi) return false;
        g.A = H; g.Bt = WinT; g.nM = 68; g.nN = 5; g.mode = M_P1; g.ldc = P1LD;
        if (l == 0) { g.sctx = 1; g.xctx = 12; g.auxc = (bf16_t*)(ws + OFF_GC); }
        return true;
    case 3:
        g.nM = mt; g.nN = 4;
        if (gi == 0 || gi == 2 || gi == 4) { g.A = H; g.Bt = WinT + (size_t)(1280 + 512 * gi) * 1024; g.mode = M_GATE; g.out = P1; g.nM = 64; return true; }
        if (l == 0) { g.sctx = 1; g.auxc = (bf16_t*)(ws + OFF_GC) + ((gi - 1) >> 1) * 1024; }
        g.out = YM; g.lda = 1280; g.ldb = 1280;
        if (gi == 1) { g.A = AM; g.Bt = WmT; g.K = 512; g.mode = M_YSET; return true; }
        if (gi == 3) { g.A = AM + 512; g.Bt = WmT + 512; g.K = 256; g.mode = M_YADD; return true; }
        if (gi == 5) { g.A = AM + 768; g.Bt = WmT + 768; g.K = 512; g.mode = M_YADD; return true; }
        return false;
    case 4:
        if (gi) return false;
        g.A = YM; g.Bt = WoT; g.nM = mt; g.nN = 4; g.mode = M_RES; g.gm = mod + 2048;
        if (l == 0) { g.xin_lat = p.x; g.xin_ctx = p.ctx; }
        return true;
    case 6:
        if (gi) return false;
        g.A = H; g.Bt = WupT; g.nM = mt; g.nN = 22; g.mode = M_UPC; g.out = (bf16_t*)(ws + OFF_ACT); g.ldc = DFF; g.aux = (const bf16_t*)(ws + OFF_HB);
        g.cw = lp->conv_w + (size_t)l * 3 * 5632;
        return true;
    case 8:
        if (gi > 1 || (gi == 1 && l != 0)) return false;
        g.A = (const bf16_t*)(ws + OFF_ACT); g.lda = DFF; g.Bt = WdT; g.ldb = DFF; g.K = DFF; g.nM = 64; g.nN = 4; g.mode = M_RES; g.gm = mod + 5120;
        if (gi == 1) { g.splitk = 1; g.K = SK_NT * BK; }
        return true;
    }
    return false;
}


__device__ __forceinline__ bool gemm_phase(LAS unsigned char* lds, int l, int sub, int gi, bool dry = false) {
    GD g; if (!make_gd((LAS const Params*)(lds + PRM_OFF), l, sub, gi, g)) return false;
    g.A = uptr(g.A); g.Bt = uptr(g.Bt); g.lda = __builtin_amdgcn_readfirstlane(g.lda); g.ldb = __builtin_amdgcn_readfirstlane(g.ldb); g.K = __builtin_amdgcn_readfirstlane(g.K);
    g.nM = __builtin_amdgcn_readfirstlane(g.nM); g.splitk = __builtin_amdgcn_readfirstlane(g.splitk); g.xctx = __builtin_amdgcn_readfirstlane(g.xctx); g.sctx = __builtin_amdgcn_readfirstlane(g.sctx); g.nN = __builtin_amdgcn_readfirstlane(g.nN); g.mode = __builtin_amdgcn_readfirstlane(g.mode);
    if (sub == 1) {
        GAS const u32x4* rt = (GAS const u32x4*)(unsigned long long)(((LAS const Params*)(lds + PRM_OFF))->ws + OFF_ROPE);
        const int t0 = otid();
        *(LAS u32x4*)(lds + 139264 + t0 * 16) = rt[t0];
    }
    if (sub == 8) {
        LAS const Params* lp = (LAS const Params*)(lds + PRM_OFF);
        unsigned char* ws = lp->ws; const float* cwp = lp->conv_w + (size_t)l * 3 * 5632;
        Unit fu;
        for (int i = 0; unit_next(g, i, fu); ++i) fixup_tile((const bf16_t*)(ws + OFF_HB), (bf16_t*)(ws + OFF_ACT), cwp, fu.pm);
        asm volatile("s_waitcnt vmcnt(0)" ::: "memory");
        __syncthreads();
    }
    const int tid = otid(), wid = __builtin_amdgcn_readfirstlane(tid >> 6), lane = tid & 63, wr = wid >> 2, wc = wid & 3, fr = lane & 15, fq = lane >> 4;
    const int K = g.K, nt = K / BK;
    const bool perm = (g.mode != M_RES);
    unsigned voffA[2], voffB[2];
#pragma unroll
    for (int i = 0; i < 2; ++i) { int R, C; stage_rc(tid * 16 + i * 8192, R, C); const int Rb = perm ? ((R & ~31) + perm32(R & 31)) : R;
        const int Ra = (g.mode == M_UPC) ? ((R & ~63) + 4 * (R & 15) + ((R >> 4) & 3)) : R;
        voffA[i] = (unsigned)(Ra * g.lda + C) * 2u; voffB[i] = (unsigned)(Rb * g.ldb + C) * 2u; }
    const size_t kstep = (size_t)(BK * 2);
    const size_t hstepA = (size_t)HALF * g.lda * 2, hstepB = (size_t)HALF * g.ldb * 2;
    const size_t tstepA = 2 * hstepA, tstepB = 2 * hstepB;
    const unsigned ldsw = (unsigned)wid * 1024u;
    const int aoff = lds_byte(wr * 64 + fr, fq * 8), boff = lds_byte(wc * 32 + fr, fq * 8);
#define PG8_SA(b, h) (((b) * 2 + (h)) * HTB)
#define PG8_SB(b, h) ((4 + (b) * 2 + (h)) * HTB)
#define PG8_STAGE(bufoff, gbase, voff) do { _Pragma("unroll") for (int _i = 0; _i < 2; ++_i) \
        __builtin_amdgcn_global_load_lds((const unsigned*)((const char*)(gbase) + (voff)[_i]), (LAS unsigned*)(lds + (bufoff) + ldsw + _i * 8192), 16, 0, 0); } while (0)
#define PG8_LDA(dst, b, h) do { _Pragma("unroll") for (int m = 0; m < 4; ++m) _Pragma("unroll") for (int k = 0; k < 2; ++k) dst[m][k] = *(const LAS bf16x8*)(lds + PG8_SA(b, h) + aoff + m * 2048 + k * 1024); } while (0)
#define PG8_LDB(dst, b, h) do { _Pragma("unroll") for (int n = 0; n < 2; ++n) _Pragma("unroll") for (int k = 0; k < 2; ++k) dst[n][k] = *(const LAS bf16x8*)(lds + PG8_SB(b, h) + boff + n * 2048 + k * 1024); } while (0)
#define PG8_MMA(ai, bj, At, Bt) do { __builtin_amdgcn_s_setprio(1); _Pragma("unroll") for (int m = 0; m < 4; ++m) _Pragma("unroll") for (int n = 0; n < 2; ++n) _Pragma("unroll") for (int k = 0; k < 2; ++k) \
        acc[ai][bj][m][n] = __builtin_amdgcn_mfma_f32_16x16x32_bf16(Bt[n][k], At[m][k], acc[ai][bj][m][n], 0, 0, 0); __builtin_amdgcn_s_setprio(0); } while (0)
#define PG8_WAIT_V(n) asm volatile("s_waitcnt vmcnt(" #n ")" ::: "memory")
#define PG8_WAIT_L(n) asm volatile("s_waitcnt lgkmcnt(" #n ")" ::: "memory")
#define PG8_BAR __builtin_amdgcn_s_barrier()
#define PG8_SCHED __builtin_amdgcn_sched_barrier(0)
    Unit cur, nxt; int ui = 0;
    if (!unit_next(g, 0, cur)) return true;
    f32x4 acc[2][2][4][2];
#pragma unroll
    for (int a = 0; a < 2; ++a)
#pragma unroll
        for (int b = 0; b < 2; ++b)
#pragma unroll
            for (int m = 0; m < 4; ++m)
#pragma unroll
                for (int n = 0; n < 2; ++n) acc[a][b][m][n] = (f32x4){0.f, 0.f, 0.f, 0.f};
    bf16x8 At[4][2], B0[2][2], B1[2][2];
    const char* cA = (const char*)g.A + (size_t)cur.pm * tstepA + (size_t)cur.k0 * kstep; const char* cB = (const char*)g.Bt + (size_t)cur.pn * tstepB + (size_t)cur.k0 * kstep;
    PG8_STAGE(PG8_SB(0, 0), cB, voffB); PG8_STAGE(PG8_SA(0, 0), cA, voffA); PG8_STAGE(PG8_SB(0, 1), cB + hstepB, voffB); PG8_STAGE(PG8_SA(0, 1), cA + hstepA, voffA);
    if (wr == 1) PG8_BAR;
    PG8_WAIT_V(4); PG8_BAR;
    PG8_STAGE(PG8_SB(1, 0), cB + kstep, voffB); PG8_STAGE(PG8_SA(1, 0), cA + kstep, voffA); PG8_STAGE(PG8_SB(1, 1), cB + hstepB + kstep, voffB);
    PG8_WAIT_V(6); PG8_BAR;
    for (;;) {
        const bool has_next = unit_next(g, ui + 1, nxt);
        const char* nA = has_next ? (const char*)g.A + (size_t)nxt.pm * tstepA + (size_t)nxt.k0 * kstep : cA; const char* nB = has_next ? (const char*)g.Bt + (size_t)nxt.pn * tstepB + (size_t)nxt.k0 * kstep : cB;
        for (int t = 0; t < nt; t += 2) {
            const bool last = (t == nt - 2);
            const char* a1 = cA + (size_t)(t + 1) * kstep;
            const char* a2 = last ? nA : cA + (size_t)(t + 2) * kstep; const char* b2 = last ? nB : cB + (size_t)(t + 2) * kstep;
            const char* a3 = a2 + kstep; const char* b3 = b2 + kstep;
            PG8_LDB(B0, 0, 0); PG8_SCHED; PG8_LDA(At, 0, 0); PG8_STAGE(PG8_SA(1, 1), a1 + hstepA, voffA);
            PG8_WAIT_L(8); PG8_BAR; PG8_WAIT_L(0); PG8_MMA(0, 0, At, B0); PG8_BAR; PG8_SCHED;
            PG8_LDB(B1, 0, 1); PG8_STAGE(PG8_SB(0, 0), b2, voffB);
            PG8_BAR; PG8_WAIT_L(0); PG8_MMA(0, 1, At, B1); PG8_BAR;
            PG8_LDA(At, 0, 1); PG8_STAGE(PG8_SA(0, 0), a2, voffA);
            PG8_BAR; PG8_WAIT_L(0); PG8_MMA(1, 0, At, B0); PG8_BAR; PG8_SCHED;
            PG8_STAGE(PG8_SB(0, 1), b2 + hstepB, voffB);
            PG8_WAIT_V(6); PG8_BAR; PG8_MMA(1, 1, At, B1); PG8_BAR;
            PG8_LDB(B0, 1, 0); PG8_SCHED; PG8_LDA(At, 1, 0); PG8_STAGE(PG8_SA(0, 1), a2 + hstepA, voffA);
            PG8_WAIT_L(8); PG8_BAR; PG8_WAIT_L(0); PG8_MMA(0, 0, At, B0); PG8_BAR; PG8_SCHED;
            PG8_LDB(B1, 1, 1); PG8_STAGE(PG8_SB(1, 0), b3, voffB);
            PG8_BAR; PG8_WAIT_L(0); PG8_MMA(0, 1, At, B1); PG8_BAR;
            PG8_LDA(At, 1, 1); PG8_STAGE(PG8_SA(1, 0), a3, voffA);
            PG8_BAR; PG8_WAIT_L(0); PG8_MMA(1, 0, At, B0); PG8_BAR; PG8_SCHED;
            PG8_STAGE(PG8_SB(1, 1), b3 + hstepB, voffB);
            PG8_WAIT_V(6); PG8_BAR; PG8_MMA(1, 1, At, B1); PG8_BAR;
        }
        __builtin_amdgcn_sched_barrier(0); asm volatile("" ::: "memory");
        if (!dry) { GD g2; make_gd((LAS const Params*)(lds + PRM_OFF), l, sub, gi, g2); gemm_epilogue(lds, g2, acc, cur); }
        if (!has_next) break;
#pragma unroll
        for (int a = 0; a < 2; ++a)
#pragma unroll
            for (int b = 0; b < 2; ++b)
#pragma unroll
                for (int m = 0; m < 4; ++m)
#pragma unroll
                    for (int n = 0; n < 2; ++n) acc[a][b][m][n] = (f32x4){0.f, 0.f, 0.f, 0.f};
        cur = nxt; cA = nA; cB = nB; ++ui;
    }
    PG8_WAIT_V(0);
    if (wr == 0) PG8_BAR;
    PG8_BAR;
    return true;
#undef PG8_SA
#undef PG8_SB
#undef PG8_STAGE
#undef PG8_LDA
#undef PG8_LDB
#undef PG8_MMA
#undef PG8_WAIT_V
#undef PG8_WAIT_L
#undef PG8_BAR
#undef PG8_SCHED
}

__device__ __forceinline__ void transpose_tile(const float* W, int N, bf16_t* WT, int ldd, int kb, int nb, int upmap, LAS float* scr) {
    const int tid = otid(), k0 = kb * 64, n0 = nb * 256;
    GAS const float* src = (GAS const float*)(unsigned long long)W + (size_t)k0 * N + n0;
    float tv[32];
#pragma unroll
    for (int i = 0; i < 32; ++i) { const int kk = i * 2 + (tid >> 8), nn = tid & 255; tv[i] = src[(size_t)kk * N + nn]; }
    asm volatile("" ::: "memory");
#pragma unroll
    for (int i = 0; i < 32; ++i) { const int kk = i * 2 + (tid >> 8), nn = tid & 255; scr[kk * 257 + nn] = tv[i]; }
    __syncthreads();
    const int c = tid & 7;
    GAS bf16_t* dst = (GAS bf16_t*)(unsigned long long)WT;
#pragma unroll
    for (int q = 0; q < 4; ++q) {
        const int n = (tid >> 3) + 64 * q; const LAS float* sp = scr + (8 * c) * 257 + n;
        u32x4 o; o.x = pk2(sp[0], sp[257]); o.y = pk2(sp[514], sp[771]); o.z = pk2(sp[1028], sp[1285]); o.w = pk2(sp[1542], sp[1799]);
        int nd = n0 + n;
        if (upmap) { nd = (nd < DFF) ? (256 * (nd >> 7) + (nd & 127)) : (256 * ((nd - DFF) >> 7) + 128 + ((nd - DFF) & 127)); }
        *(GAS u32x4*)(dst + (size_t)nd * ldd + k0 + 8 * c) = o;
    }
    __syncthreads();
}

__device__ void phase_prep(const Params& p, LAS unsigned char* lds) {
    const int tid = otid();
    LAS float* scr = (LAS float*)lds;
    constexpr int T_IN = 16 * 17, T_BA = 8 * 4, T_WO = 16 * 4, T_UP = 16 * 22, T_DN = 44 * 4, T_L = T_IN + T_BA + T_WO + T_UP + T_DN;
    constexpr int I_TR = 2 * T_L, I_POOL = I_TR + 128, I_FOUR = I_POOL + 256, I_MOD = I_FOUR + 192, I_ALL = I_MOD + 1;
    for (int prep_rep = 0; prep_rep < ((PROBE >= 301 && PROBE <= 304) ? 2 : 1); ++prep_rep)
    for (int it = blockIdx.x; it < I_ALL; it += gridDim.x) {
#if PROBE >= 301 && PROBE <= 304
        if (prep_rep == 1) { const int cls = (it < I_TR) ? 301 : (it < I_FOUR) ? 302 : (it < I_MOD) ? 303 : 304; if (cls != PROBE) continue; }
#endif
        if (it < I_TR) {
            const int l = it / T_L; int j = it % T_L;
            unsigned char* wb = p.ws + OFF_W + (size_t)l * LW;
            if (j < T_IN) transpose_tile(p.w_in + (size_t)l * 1024 * INW, INW, (bf16_t*)(wb + LW_WIN), 1024, j / 17, j % 17, 0, scr);
            else if ((j -= T_IN) < T_BA) transpose_tile(p.w_br_attn + (size_t)l * 512 * 1024, 1024, (bf16_t*)(wb + LW_WM), 1280, j / 4, j % 4, 0, scr);
            else if ((j -= T_BA) < T_WO) transpose_tile(p.w_out + (size_t)l * 1024 * 1024, 1024, (bf16_t*)(wb + LW_WO), 1024, j / 4, j % 4, 0, scr);
            else if ((j -= T_WO) < T_UP) transpose_tile(p.w_up + (size_t)l * 1024 * 5632, 5632, (bf16_t*)(wb + LW_WUP), 1024, j / 22, j % 22, 1, scr);
            else { j -= T_UP; transpose_tile(p.w_down + (size_t)l * DFF * 1024, 1024, (bf16_t*)(wb + LW_WD), DFF, j / 4, j % 4, 0, scr); }
        } else if (it < I_POOL) {
            const int j = it - I_TR, l = j >> 6, g = (j >> 4) & 3, nb = j & 15;
            const int n = nb * 64 + (tid & 63), co = tid >> 6;
            const float* pw = p.pool_w + (size_t)l * 16384 + g * 4096 + (8 * co) * 64;
            const float* sc = p.pool_scale + l * 256 + g * 64;
            const float* wb = p.w_br_pool + (size_t)l * 256 * 1024 + (size_t)(g * 64) * 1024 + n;
            float a[8];
#pragma unroll
            for (int q = 0; q < 8; ++q) a[q] = 0.f;
#pragma unroll 1
            for (int d0 = 0; d0 < 64; d0 += 16) {
                float wv[16];
#pragma unroll
                for (int dd = 0; dd < 16; ++dd) wv[dd] = ((GAS const float*)(unsigned long long)wb)[(size_t)(d0 + dd) * 1024];
                asm volatile("" ::: "memory");
#pragma unroll
                for (int dd = 0; dd < 16; ++dd) { const float w = sc[d0 + dd] * wv[dd];
#pragma unroll
                    for (int q = 0; q < 8; ++q) a[q] += pw[q * 64 + d0 + dd] * w; }
            }
            bf16_t* dst = (bf16_t*)(p.ws + OFF_W + (size_t)l * LW + LW_WM) + (size_t)n * 1280 + 512 + g * 64 + 8 * co;
            u32x4 o; o.x = pk2(a[0], a[1]); o.y = pk2(a[2], a[3]); o.z = pk2(a[4], a[5]); o.w = pk2(a[6], a[7]);
            *(u32x4*)dst = o;
        } else if (it < I_FOUR) {
            const int j = it - I_POOL, l = j >> 7, g = (j >> 5) & 3, nb = (j >> 1) & 15, part = j & 1;
            if (tid < 64) { float sv, cv; sincospif((float)tid / 32.f, &sv, &cv); scr[tid] = part ? sv : cv; }
            __syncthreads();
            const int n = nb * 64 + (tid & 63), co = tid >> 6;
            const float* wb = p.w_br_four + (size_t)l * 256 * 1024 + (size_t)(g * 64) * 1024 + n;
            float a[8];
#pragma unroll
            for (int q = 0; q < 8; ++q) a[q] = 0.f;
#pragma unroll 1
            for (int m0 = 0; m0 < 64; m0 += 16) {
                float wv[16];
#pragma unroll
                for (int dd = 0; dd < 16; ++dd) wv[dd] = ((GAS const float*)(unsigned long long)wb)[(size_t)(m0 + dd) * 1024];
                asm volatile("" ::: "memory");
#pragma unroll
                for (int dd = 0; dd < 16; ++dd) { const int m = m0 + dd; const float w = wv[dd];
#pragma unroll
                    for (int q = 0; q < 8; ++q) a[q] += scr[(m * (8 * co + q)) & 63] * w; }
            }
            bf16_t* dst = (bf16_t*)(p.ws + OFF_W + (size_t)l * LW + LW_WM) + (size_t)n * 1280 + 768 + g * 128 + part * 64 + 8 * co;
            u32x4 o; o.x = pk2(a[0], a[1]); o.y = pk2(a[2], a[3]); o.z = pk2(a[4], a[5]); o.w = pk2(a[6], a[7]);
            *(u32x4*)dst = o;
            __syncthreads();
        } else if (it < I_MOD) {
            const int j = it - I_FOUR, l = j / 96, cb = j % 96;
            for (int i = tid; i < 5 * 1024; i += 512) { const int r = i >> 10, k = i & 1023; const float v = (r < 4) ? p.c[r * 1024 + k] : p.c_ctx[k]; scr[i] = v / (1.f + __expf(-v)); }
            __syncthreads();
            const int col = cb * 64 + (tid & 63), ks = tid >> 6;
            GAS const float* wm = (GAS const float*)(unsigned long long)p.w_mod + (size_t)l * 1024 * 6144 + col;
            float a0 = 0.f, a1 = 0.f, a2 = 0.f, a3 = 0.f, a4 = 0.f;
#pragma unroll 1
            for (int k0 = ks * 128; k0 < ks * 128 + 128; k0 += 32) {
                float wv[32];
#pragma unroll
                for (int q = 0; q < 32; ++q) wv[q] = wm[(size_t)(k0 + q) * 6144];
                asm volatile("" ::: "memory");
#pragma unroll
                for (int q = 0; q < 32; ++q) { const int k = k0 + q; const float w = wv[q];
                    a0 += scr[k] * w; a1 += scr[1024 + k] * w; a2 += scr[2048 + k] * w; a3 += scr[3072 + k] * w; a4 += scr[4096 + k] * w; }
            }
            __syncthreads();
            LAS float* part = scr + 5120;
            part[(ks * 5 + 0) * 64 + (tid & 63)] = a0; part[(ks * 5 + 1) * 64 + (tid & 63)] = a1; part[(ks * 5 + 2) * 64 + (tid & 63)] = a2;
            part[(ks * 5 + 3) * 64 + (tid & 63)] = a3; part[(ks * 5 + 4) * 64 + (tid & 63)] = a4;
            __syncthreads();
            if (tid < 320) { const int r = tid >> 6, cc = tid & 63; float s = p.b_mod[l * 6144 + cb * 64 + cc];
#pragma unroll
                for (int q = 0; q < 8; ++q) s += part[(q * 5 + r) * 64 + cc];
                ((float*)(p.ws + OFF_MOD))[(size_t)(l * 5 + r) * 6144 + cb * 64 + cc] = s; }
            __syncthreads();
        } else {
            float* rope = (float*)(p.ws + OFF_ROPE); float* tw = (float*)(p.ws + OFF_TW);
            for (int i = tid; i < 1024; i += 512) { const int pos = i >> 4, f = i & 15; const float inv = powf(10000.f, -(float)f / 16.f); const float ang = (float)pos * inv;
                rope[2 * i] = cosf(ang); rope[2 * i + 1] = sinf(ang); }
            for (int i = tid; i < 4095; i += 512) { const int sh = 31 - __clz(i + 1), half = 1 << sh, j = i + 1 - half; float sv, cv; sincospif((float)j / (float)half, &sv, &cv); tw[2 * i] = cv; tw[2 * i + 1] = sv; }
        }
    }
}

__device__ void phase_norm(const Params& p, int l, int which) {
    const int tid = otid(), lane = tid & 63, gw = blockIdx.x * 8 + (tid >> 6), nw = gridDim.x * 8;
    const int nrows = (l == 1 && which == 1) ? NL : NR;
    const bool first = (l == 0 && which == 0);
    GAS const f32x4* gn = (GAS const f32x4*)(unsigned long long)((which ? p.norm_ffn : p.norm_mix) + l * 1024);
    GAS const float* mod = (GAS const float*)(unsigned long long)(p.ws + OFF_MOD) + (size_t)l * 5 * 6144 + (which ? 3072 : 0);
    GAS bf16_t* H = (GAS bf16_t*)(unsigned long long)(p.ws + OFF_H);
    for (int row = gw; row < nrows; row += nw) {
        GAS const f32x4* xr; int rb;
        if (row < NL) { xr = (GAS const f32x4*)(unsigned long long)((first ? p.x : p.out) + (size_t)row * DM); rb = row >> 12; }
        else { xr = (GAS const f32x4*)(unsigned long long)((first ? p.ctx : (const float*)(p.ws + OFF_XC)) + (size_t)(row - NL) * DM); rb = 4; }
        GAS const f32x4* sh = (GAS const f32x4*)(mod + rb * 6144); GAS const f32x4* sc = (GAS const f32x4*)(mod + rb * 6144 + 1024);
        f32x4 v[4], g4[4], s4[4], h4[4];
#pragma unroll
        for (int j = 0; j < 4; ++j) { v[j] = xr[lane + 64 * j]; g4[j] = gn[lane + 64 * j]; s4[j] = sc[lane + 64 * j]; h4[j] = sh[lane + 64 * j]; }
        asm volatile("" ::: "memory");
        if (l == 1 && which == 0 && row >= NL) {
            GAS const f32x4* pp = (GAS const f32x4*)(unsigned long long)((const float*)(p.ws + OFF_PART) + (size_t)(row - NL) * DM);
#pragma unroll 1
            for (int ks = 0; ks < SK_S; ++ks) {
                f32x4 t[4];
#pragma unroll
                for (int j = 0; j < 4; ++j) t[j] = pp[(size_t)ks * (1024 * DM / 4) + lane + 64 * j];
                asm volatile("" ::: "memory");
#pragma unroll
                for (int j = 0; j < 4; ++j) v[j] += t[j];
            }
        }
        float s = 0.f;
#pragma unroll
        for (int j = 0; j < 4; ++j) s += (v[j].x * v[j].x + v[j].y * v[j].y) + (v[j].z * v[j].z + v[j].w * v[j].w);
        const float rstd = rsqrtf(wave_sum(s) * (1.f / 1024.f) + 1e-6f);
#pragma unroll
        for (int j = 0; j < 4; ++j) {
            const f32x4 y = v[j] * rstd * g4[j] * (s4[j] + 1.f) + h4[j];
            u32x2 o; o.x = pk2(y.x, y.y); o.y = pk2(y.z, y.w);
            ((GAS u32x2*)(H + (size_t)row * DM))[lane + 64 * j] = o;
        }
    }
}

__device__ void phase_final(const Params& p) {
    const int tid = otid(), lane = tid & 63, gw = blockIdx.x * 8 + (tid >> 6), nw = gridDim.x * 8;
    GAS const f32x4* gf = (GAS const f32x4*)(unsigned long long)p.norm_final;
    for (int row = gw; row < NL; row += nw) {
        GAS f32x4* xr = (GAS f32x4*)(unsigned long long)(p.out + (size_t)row * DM);
        f32x4 v[4], g4[4];
#pragma unroll
        for (int j = 0; j < 4; ++j) { v[j] = xr[lane + 64 * j]; g4[j] = gf[lane + 64 * j]; }
        asm volatile("" ::: "memory");
        float s = 0.f;
#pragma unroll
        for (int j = 0; j < 4; ++j) s += (v[j].x * v[j].x + v[j].y * v[j].y) + (v[j].z * v[j].z + v[j].w * v[j].w);
        const float rstd = rsqrtf(wave_sum(s) * (1.f / 1024.f) + 1e-6f);
#pragma unroll
        for (int j = 0; j < 4; ++j) xr[lane + 64 * j] = v[j] * rstd * g4[j];
    }
}

constexpr int KPITCH = 144, VPITCH = 272;
__device__ void attn_item(const Params& p, int l, int item, LAS unsigned char* lds) {
    const int tid = otid(), wid = __builtin_amdgcn_readfirstlane(tid >> 6), lane = tid & 63, l31 = lane & 31, hi = lane >> 5;
    const bool isctx = item >= 512;
    int b, n, h, hb, qrow0;
    if (!isctx) { b = item >> 7; n = (item >> 2) & 31; h = (item >> 1) & 1; hb = item & 1; qrow0 = b * 4096 + n * 128; }
    else { const int j = item - 512; b = j >> 3; n = (j >> 2) & 1; h = (j >> 1) & 1; hb = j & 1; qrow0 = NL + b * 256 + n * 128; }
    const bf16_t* P1 = (const bf16_t*)(p.ws + OFF_P1);
    bf16_t* AM = (bf16_t*)(p.ws + OFF_AM);
    LAS unsigned char* Kl = lds; LAS unsigned char* Vt = lds + 128 * KPITCH;
    const int g = wid >> 1, head = 4 * h + g, qq = 64 * hb + 32 * (wid & 1) + l31;
    bf16x8 qf[4];
#pragma unroll
    for (int ks = 0; ks < 4; ++ks) {
        const u32x4 w = *(const u32x4*)(P1 + (size_t)(qrow0 + qq) * P1LD + 256 + head * 64 + 16 * ks + 8 * hi);
        u32x4 o; o.x = pk2(bflo(w.x) * 0.125f, bfhi(w.x) * 0.125f); o.y = pk2(bflo(w.y) * 0.125f, bfhi(w.y) * 0.125f);
        o.z = pk2(bflo(w.z) * 0.125f, bfhi(w.z) * 0.125f); o.w = pk2(bflo(w.w) * 0.125f, bfhi(w.w) * 0.125f);
        qf[ks] = __builtin_bit_cast(bf16x8, o);
    }
    f32x16 ot[2];
    float mrun = -1e30f, lrun = 0.f;
#pragma unroll
    for (int dt = 0; dt < 2; ++dt)
#pragma unroll
        for (int r = 0; r < 16; ++r) ot[dt][r] = 0.f;
    GAS const bf16_t* P1g = (GAS const bf16_t*)(unsigned long long)P1;
    const int pr = tid & 63, vslab = tid >> 6;
#define ATT_NEXT(c_) ({ int _c = (c_) + 1; if (!isctx) { if (_c == 1 && n == 0) _c = 2; if (_c == 2 && n == 31) _c = 3; } _c; })
#define ATT_KBASE(c_) ((c_) == 0 ? qrow0 : (c_) == 1 ? qrow0 - 128 : (c_) == 2 ? qrow0 + 128 : NL + b * 256 + ((c_) - 3) * 128)
    u32x4 kw[2], w0, w1;
    {
        const int kb0 = ATT_KBASE(isctx ? 3 : 0);
#pragma unroll
        for (int i = 0; i < 2; ++i) { const int q = tid + 512 * i, key = q >> 3, slab = q & 7;
            kw[i] = *(GAS const u32x4*)(P1g + (size_t)(kb0 + key) * P1LD + 64 * h + 8 * slab); }
        w0 = *(GAS const u32x4*)(P1g + (size_t)(kb0 + 2 * pr) * P1LD + 128 + 64 * h + 8 * vslab);
        w1 = *(GAS const u32x4*)(P1g + (size_t)(kb0 + 2 * pr + 1) * P1LD + 128 + 64 * h + 8 * vslab);
    }
#pragma unroll 1
    for (int ci = isctx ? 3 : 0; ci < 5; ci = ATT_NEXT(ci)) {
        const int mask = (ci == 1) ? 1 : (ci == 2) ? 2 : 0;
        asm volatile("" ::: "memory");
        __syncthreads();
        {
#pragma unroll
            for (int i = 0; i < 2; ++i) { const int q = tid + 512 * i, key = q >> 3, slab = q & 7; *(LAS u32x4*)(Kl + key * KPITCH + 16 * slab) = kw[i]; }
            LAS unsigned char* vb = Vt + (8 * vslab) * VPITCH + 4 * pr;
            *(LAS unsigned*)(vb + 0 * VPITCH) = (w0.x & 0xffffu) | (w1.x << 16); *(LAS unsigned*)(vb + 1 * VPITCH) = (w0.x >> 16) | (w1.x & 0xffff0000u);
            *(LAS unsigned*)(vb + 2 * VPITCH) = (w0.y & 0xffffu) | (w1.y << 16); *(LAS unsigned*)(vb + 3 * VPITCH) = (w0.y >> 16) | (w1.y & 0xffff0000u);
            *(LAS unsigned*)(vb + 4 * VPITCH) = (w0.z & 0xffffu) | (w1.z << 16); *(LAS unsigned*)(vb + 5 * VPITCH) = (w0.z >> 16) | (w1.z & 0xffff0000u);
            *(LAS unsigned*)(vb + 6 * VPITCH) = (w0.w & 0xffffu) | (w1.w << 16); *(LAS unsigned*)(vb + 7 * VPITCH) = (w0.w >> 16) | (w1.w & 0xffff0000u);
        }
        __syncthreads();
        {
            const int cn = ATT_NEXT(ci);
            if (cn < 5) {
                const int kbn = ATT_KBASE(cn);
#pragma unroll
                for (int i = 0; i < 2; ++i) { const int q = tid + 512 * i, key = q >> 3, slab = q & 7;
                    kw[i] = *(GAS const u32x4*)(P1g + (size_t)(kbn + key) * P1LD + 64 * h + 8 * slab); }
                w0 = *(GAS const u32x4*)(P1g + (size_t)(kbn + 2 * pr) * P1LD + 128 + 64 * h + 8 * vslab);
                w1 = *(GAS const u32x4*)(P1g + (size_t)(kbn + 2 * pr + 1) * P1LD + 128 + 64 * h + 8 * vslab);
            }
            asm volatile("" ::: "memory");
        }
        f32x16 st[4];
#pragma unroll
        for (int kt = 0; kt < 4; ++kt) {
#pragma unroll
            for (int r = 0; r < 16; ++r) st[kt][r] = 0.f;
#pragma unroll
            for (int ks = 0; ks < 4; ++ks) {
                const bf16x8 kf = *(const LAS bf16x8*)(Kl + (32 * kt + l31) * KPITCH + 32 * ks + 16 * hi);
                st[kt] = __builtin_amdgcn_mfma_f32_32x32x16_bf16(kf, qf[ks], st[kt], 0, 0, 0);
            }
        }
        __builtin_amdgcn_sched_barrier(0);
        float mx = -1e30f;
        if (mask) {
            int klo = (mask == 1) ? qq : -1, khi = (mask == 2) ? qq : 1000;
            asm volatile("" : "+v"(klo), "+v"(khi));
#pragma unroll
            for (int kt = 0; kt < 4; ++kt)
#pragma unroll
                for (int r = 0; r < 16; ++r) {
                    const int kk = 32 * kt + 8 * (r >> 2) + 4 * hi + (r & 3);
                    st[kt][r] = (kk >= klo && kk <= khi) ? st[kt][r] : -1e30f;
                }
        }
#pragma unroll
        for (int kt = 0; kt < 4; ++kt)
#pragma unroll
            for (int r = 0; r < 16; ++r) mx = fmaxf(mx, st[kt][r]);
        mx = fmaxf(mx, __shfl_xor(mx, 32)) * LOG2E;
        const float mnew = fmaxf(mrun, mx), alpha = __builtin_amdgcn_exp2f(mrun - mnew);
        float rs = 0.f;
        __builtin_amdgcn_sched_barrier(0);
#pragma unroll
        for (int kt = 0; kt < 4; ++kt)
#pragma unroll
            for (int r = 0; r < 16; ++r) { const float e = __builtin_amdgcn_exp2f(fmaf(st[kt][r], LOG2E, -mnew)); st[kt][r] = e; rs += e; }
        rs += __shfl_xor(rs, 32);
        lrun = lrun * alpha + rs; mrun = mnew;
#pragma unroll
        for (int dt = 0; dt < 2; ++dt)
#pragma unroll
            for (int r = 0; r < 16; ++r) ot[dt][r] *= alpha;
#pragma unroll
        for (int kt = 0; kt < 4; ++kt)
#pragma unroll
            for (int s = 0; s < 2; ++s) {
                __builtin_amdgcn_sched_barrier(0);
                u32x4 pw; pw.x = pk2(st[kt][8 * s + 0], st[kt][8 * s + 1]); pw.y = pk2(st[kt][8 * s + 2], st[kt][8 * s + 3]);
                pw.z = pk2(st[kt][8 * s + 4], st[kt][8 * s + 5]); pw.w = pk2(st[kt][8 * s + 6], st[kt][8 * s + 7]);
                const bf16x8 pf = __builtin_bit_cast(bf16x8, pw);
#pragma unroll
                for (int dt = 0; dt < 2; ++dt) {
                    const LAS unsigned char* va = Vt + (32 * dt + l31) * VPITCH + (32 * kt + 16 * s + 4 * hi) * 2;
                    const u32x2 a0 = *(const LAS u32x2*)va, a1 = *(const LAS u32x2*)(va + 16);
                    u32x4 aw; aw.x = a0.x; aw.y = a0.y; aw.z = a1.x; aw.w = a1.y;
                    ot[dt] = __builtin_amdgcn_mfma_f32_32x32x16_bf16(__builtin_bit_cast(bf16x8, aw), pf, ot[dt], 0, 0, 0);
                }
            }
    }
    const float sink = p.attn_sink[l * 8 + head] * LOG2E;
    const float inv = 1.f / (lrun + __builtin_amdgcn_exp2f(sink - mrun));
    bf16_t* orow = AM + (size_t)(qrow0 + qq) * 1280 + head * 64;
#pragma unroll
    for (int dt = 0; dt < 2; ++dt)
#pragma unroll
        for (int rq = 0; rq < 4; ++rq) {
            u32x2 o; o.x = pk2(ot[dt][4 * rq] * inv, ot[dt][4 * rq + 1] * inv); o.y = pk2(ot[dt][4 * rq + 2] * inv, ot[dt][4 * rq + 3] * inv);
            *(u32x2*)(orow + 32 * dt + 8 * rq + 4 * hi) = o;
        }
}

__device__ void fft_item(const Params& p, int item, bool isctx, LAS unsigned char* lds) {
    const int tid = otid();
    const int b = item >> 6, quad = item & 63;
    const int logN = isctx ? 8 : 12, N = 1 << logN;
    const int rowbase = isctx ? NL + b * 256 : b * 4096;
    LAS f32x2* data = (LAS f32x2*)lds;
    LAS f32x2* tw = (LAS f32x2*)(lds + 65536);
    __syncthreads();
    {
        GAS const bf16_t* src = (GAS const bf16_t*)(unsigned long long)(p.ws + OFF_P1) + (size_t)rowbase * P1LD + 1024 + quad * 4;
        u32x2 v[8];
#pragma unroll
        for (int q = 0; q < 8; ++q) { const int t = tid + 512 * q; v[q] = (t < N) ? *(GAS const u32x2*)(src + (size_t)t * P1LD) : (u32x2){0u, 0u}; }
        asm volatile("" ::: "memory");
#pragma unroll
        for (int q = 0; q < 8; ++q) { const int t = tid + 512 * q;
            if (t < N) { f32x2 a; a.x = bflo(v[q].x); a.y = bfhi(v[q].x); data[t] = a; f32x2 c; c.x = bflo(v[q].y); c.y = bfhi(v[q].y); data[N + t] = c; } }
    }
    __syncthreads();
    for (int sh = logN - 1; sh >= 1; sh -= 2) {
        const int q = 1 << (sh - 1), ng = 2 << (logN - 2);
        const LAS f32x2* tw1 = tw + (2 * q - 1);
        const LAS f32x2* tw2 = tw + (q - 1);
#pragma unroll 2
        for (int gi = tid; gi < ng; gi += 512) {
            const int f = gi >> (logN - 2), bb = gi & ((N >> 2) - 1);
            const int j = bb & (q - 1), i = ((bb - j) << 2) + j;
            LAS f32x2* X = data + f * N;
            const f32x2 a0 = X[i], a1 = X[i + q], a2 = X[i + 2 * q], a3 = X[i + 3 * q];
            const f32x2 wa = tw1[j], wb = tw1[j + q], wc2 = tw2[j];
            const f32x2 s0 = a0 + a2, d0 = a0 - a2, s1 = a1 + a3, d1 = a1 - a3;
            f32x2 t0, t1; t0.x = d0.x * wa.x + d0.y * wa.y; t0.y = d0.y * wa.x - d0.x * wa.y; t1.x = d1.x * wb.x + d1.y * wb.y; t1.y = d1.y * wb.x - d1.x * wb.y;
            const f32x2 e0 = s0 - s1, e1 = t0 - t1;
            f32x2 r1, r3; r1.x = e0.x * wc2.x + e0.y * wc2.y; r1.y = e0.y * wc2.x - e0.x * wc2.y; r3.x = e1.x * wc2.x + e1.y * wc2.y; r3.y = e1.y * wc2.x - e1.x * wc2.y;
            X[i] = s0 + s1; X[i + q] = r1; X[i + 2 * q] = t0 + t1; X[i + 3 * q] = r3;
        }
        __syncthreads();
    }
    const float hs = isctx ? (0.5f / 128.f) : (0.5f / 512.f);
    bf16_t* AM = (bf16_t*)(p.ws + OFF_AM);
    const int g = quad >> 4, cc0 = 4 * (quad & 15);
#pragma unroll 1
    for (int i1 = tid; i1 < N; i1 += 512) {
        const int k = (int)(__brev((unsigned)i1) >> (32 - logN));
        const int k2 = (N - k) & (N - 1);
        const int i2 = (int)(__brev((unsigned)k2) >> (32 - logN));
        float re[4], im[4];
#pragma unroll
        for (int f = 0; f < 2; ++f) {
            const f32x2 X = data[f * N + i1], Y = data[f * N + i2];
            re[2 * f] = (X.x + Y.x) * hs; im[2 * f] = (X.y - Y.y) * hs; re[2 * f + 1] = (X.y + Y.y) * hs; im[2 * f + 1] = (Y.x - X.x) * hs;
        }
        bf16_t* dst = AM + (size_t)(rowbase + k) * 1280 + 768 + g * 128 + cc0;
        u32x2 o; o.x = pk2(re[0], re[1]); o.y = pk2(re[2], re[3]);
        *(u32x2*)dst = o;
        o.x = pk2(im[0], im[1]); o.y = pk2(im[2], im[3]);
        *(u32x2*)(dst + 64) = o;
    }
}

__device__ void pool_item(const Params& p, int item) {
    const int tid = otid();
    const int row = item * 16 + (tid >> 5), co = tid & 31, w = 2 << (co >> 3);
    int base, T;
    if (row < NL) { base = row & ~4095; T = 4096; } else { base = NL + ((row - NL) & ~255); T = 256; }
    const int tt = row - base;
    int lo = tt - (w >> 1), hi = lo + w; lo = lo < 0 ? 0 : lo; hi = hi > T ? T : hi;
    const bf16_t* U = (const bf16_t*)(p.ws + OFF_P1) + 768 + 8 * co;
    float s[8];
#pragma unroll
    for (int q = 0; q < 8; ++q) s[q] = 0.f;
    const int wlo = tt - (w >> 1);
    {
        GAS const bf16_t* Ug = (GAS const bf16_t*)(unsigned long long)U;
        u32x4 pv[16];
#pragma unroll
        for (int jj = 0; jj < 16; ++jj) { int j = wlo + jj; j = j < 0 ? 0 : (j >= T ? T - 1 : j); pv[jj] = *(GAS const u32x4*)(Ug + (size_t)(base + j) * P1LD); }
        asm volatile("" ::: "memory");
#pragma unroll
        for (int jj = 0; jj < 16; ++jj) {
            const int j = wlo + jj; const float mk = (jj < w && j >= 0 && j < T) ? 1.f : 0.f; const u32x4 v = pv[jj];
            s[0] += mk * bflo(v.x); s[1] += mk * bfhi(v.x); s[2] += mk * bflo(v.y); s[3] += mk * bfhi(v.y); s[4] += mk * bflo(v.z); s[5] += mk * bfhi(v.z); s[6] += mk * bflo(v.w); s[7] += mk * bfhi(v.w);
        }
    }
    const float ic = 1.f / (float)(hi - lo);
    const u32x4 v = *(const u32x4*)(U + (size_t)row * P1LD);
    u32x4 o; o.x = pk2(s[0] * ic - bflo(v.x), s[1] * ic - bfhi(v.x)); o.y = pk2(s[2] * ic - bflo(v.y), s[3] * ic - bfhi(v.y));
    o.z = pk2(s[4] * ic - bflo(v.z), s[5] * ic - bfhi(v.z)); o.w = pk2(s[6] * ic - bflo(v.w), s[7] * ic - bfhi(v.w));
    *(u32x4*)((bf16_t*)(p.ws + OFF_AM) + (size_t)row * 1280 + 512 + 8 * co) = o;
}

__device__ void phase_mix(const Params& p, int l, LAS unsigned char* lds) {
    const int n_attn = (l == 0) ? 544 : 512, n_fft = (l == 0) ? 512 : 256, n_pool = ((l == 0) ? NR : NL) / 16;
    const int total = n_attn + n_fft + n_pool;
    { const int tid = otid(); const f32x2* TW = (const f32x2*)(p.ws + OFF_TW); LAS f32x2* tw = (LAS f32x2*)(lds + 65536);
      for (int i = tid; i < 4095; i += 512) tw[i] = TW[i]; }
    for (int rep = 0; rep < ((PROBE & 7) && PROBE < 100 ? 2 : 1); ++rep)
    for (int it = blockIdx.x; it < total; it += gridDim.x) {
        if (it < n_attn) { if (rep == 0 || (PROBE & 1)) attn_item(p, l, it, lds); }
        else if (it < n_attn + n_fft) { const int j = it - n_attn; if (rep == 0 || (PROBE & 2)) { if (j < 256) fft_item(p, j, false, lds); else fft_item(p, j - 256, true, lds); } }
        else { if (rep == 0 || (PROBE & 4)) pool_item(p, it - n_attn - n_fft); }
    }
}

constexpr int N_PHASES = 18;
__global__ void __launch_bounds__(512) mega(Params pk) {
    extern __shared__ __attribute__((aligned(16))) unsigned char shm[];
    LAS unsigned char* lds = (LAS unsigned char*)shm;
    cg::grid_group grid = cg::this_grid();
    LAS Params* lp = (LAS Params*)(lds + PRM_OFF);
    if (threadIdx.x < 23) ((LAS unsigned long long*)lp)[threadIdx.x] = ((const unsigned long long*)&pk)[threadIdx.x];
    if (threadIdx.x < 4) ((LAS unsigned*)(lds + PRM_OFF + 512))[threadIdx.x] = 0u;
    __syncthreads();
    const XcdBarrier xb = xcd_barrier_post((unsigned*)(pk.ws + OFF_BAR), (volatile LAS unsigned*)(lds + PRM_OFF + 512));
    const int ph_lo = __builtin_amdgcn_readfirstlane(lp->ph_lo), ph_hi = __builtin_amdgcn_readfirstlane(lp->ph_hi);
    for (int ph = ph_lo; ph < ph_hi; ++ph) {
        const int l = (ph - 1) / 8, sub = (ph == 0) ? 9 : (((ph - 1) % 8) == 7 ? 8 : (ph - 1) % 8);
        int nrep = 1;
#if PROBE >= 100
        if (ph < N_PHASES - 1 && sub == (PROBE % 100)) nrep = 2;
#endif
        for (int rep = 0; rep < nrep; ++rep) {
            const bool dry = (PROBE >= 200) && (rep == 0) && (nrep == 2);
            if (ph == 0) { const Params p = load_params(lp); phase_prep(p, lds); }
            else if (ph == N_PHASES - 1) { const Params p = load_params(lp); phase_final(p); }
            else if (sub == 0 || sub == 5) { const Params p = load_params(lp); phase_norm(p, l, sub == 5); }
            else if (sub == 2) { const Params p = load_params(lp); phase_mix(p, l, lds); }
            else { for (int gi = 0; gi < 6; ++gi) { if (!gemm_phase(lds, l, sub, gi, dry)) break; } }
            if (rep + 1 < nrep) xcd_barrier(xb);
        }
        if (ph + 1 < ph_hi) xcd_barrier(xb);
        if (ph_hi > 1000) grid.sync();
    }
}

extern "C" void kernel_launch(void* const* d_in, const int* in_sizes, int n_in, void* d_out, int out_size, void* d_ws, size_t ws_size, hipStream_t stream) {
    static int grid_blocks = 0;
    if (!grid_blocks) {
        int dev = 0, cus = 0, per_cu = 0;
        hipGetDevice(&dev);
        hipDeviceGetAttribute(&cus, hipDeviceAttributeMultiprocessorCount, dev);
        hipFuncSetAttribute((const void*)mega, hipFuncAttributeMaxDynamicSharedMemorySize, LDS_BYTES);
        if (hipOccupancyMaxActiveBlocksPerMultiprocessor(&per_cu, (const void*)mega, 512, LDS_BYTES) != hipSuccess || per_cu < 1) per_cu = 1;
        (void)hipGetLastError();
        if (per_cu > 1) per_cu = 1;
        grid_blocks = cus * per_cu;
        if (ws_size < 256 * MiB) fprintf(stderr, "kernel_launch: workspace too small (%zu)\n", ws_size);
    }
    Params p{};
    const float** pp = (const float**)&p;
    for (int i = 0; i < 20; ++i) pp[i] = (const float*)d_in[i];
    p.out = (float*)d_out; p.ws = (unsigned char*)d_ws; p.ph_lo = 0; p.ph_hi = N_PHASES;
    (void)hipMemsetAsync((char*)d_ws + OFF_BAR, 0, XCD_BAR_WORDS * 4, stream);
    void* args[] = {&p};
    hipError_t e = hipLaunchCooperativeKernel((const void*)mega, dim3(grid_blocks), dim3(512), args, LDS_BYTES, stream);
    if (e != hipSuccess) fprintf(stderr, "cooperative launch failed: %s (grid %d)\n", hipGetErrorString(e), grid_blocks);
}
```
